# Optimizing an MI355X kernel written in HIP

```python
import math
import jax, jax.numpy as jnp
from jax import lax
import numpy as np

D_MODEL = 2048
BATCH = 1
SEQ = 8192
DEPTH = 1

D_MIX = D_MODEL
HEAD_DIM = 64
D_RWKV = D_MIX // 2
N_RWKV_HEADS = D_RWKV // HEAD_DIM
DECAY_LORA = 64
AAA_LORA = 64
D_ATT = D_MIX - D_RWKV
N_Q_HEADS = D_ATT // HEAD_DIM
N_KV_HEADS = 2
KV_GROUP = N_Q_HEADS // N_KV_HEADS
D_KV = N_KV_HEADS * HEAD_DIM
WINDOW = 128
BLOCK = 128
N_BUCKETS = 32
MAX_EXACT = N_BUCKETS // 2
MAX_DISTANCE = 128
NORM_EPS = 1e-6
LNX_EPS = 64e-5
RWKV_SPLITS = [D_RWKV, 2 * D_RWKV, 3 * D_RWKV, 4 * D_RWKV, 4 * D_RWKV + DECAY_LORA]
RWKV_COLS = 4 * D_RWKV + DECAY_LORA + AAA_LORA
ATT_SPLITS = [D_ATT, D_ATT + D_KV, D_ATT + 2 * D_KV]
ATT_COLS = 2 * D_ATT + 2 * D_KV
D_IN = RWKV_COLS + ATT_COLS

kernel_name = "hymba_rwkv7_swa_sink_hybrid"


def rms_norm(x, g, eps):
    xf = x.astype(jnp.float32)
    y = xf * lax.rsqrt(jnp.mean(xf * xf, axis=-1, keepdims=True) + eps)
    return y * g.astype(jnp.float32)


def rwkv7_mixer(z, mu, w0, w2, a0, a2, k_k, k_a, r_k, lnx_w, lnx_b):
    B_, S_ = z.shape[0], z.shape[1]
    z_prev = jnp.pad(z, ((0, 0), (1, 0), (0, 0)))[:, :-1]
    z = z + (z_prev - z) * mu
    r, k, v, g, wl, al = jnp.split(z, RWKV_SPLITS, axis=-1)
    w = -jax.nn.softplus(-(w0 + jnp.tanh(wl) @ w2)) - 0.5
    decay = jnp.exp(-jnp.exp(w))
    a = jax.nn.sigmoid(a0 + al @ a2)
    hs = lambda t: t.reshape(B_, S_, N_RWKV_HEADS, HEAD_DIM)
    kk = hs(k * k_k)
    kk = kk * lax.rsqrt(jnp.maximum(jnp.sum(kk * kk, axis=-1, keepdims=True), 1e-24))
    k = k * (1.0 + (a - 1.0) * k_a)
    r, k, v, decay, a = hs(r), hs(k), hs(v), hs(decay), hs(a)

    def step(state, inp):
        r_t, w_t, k_t, v_t, kk_t, a_t = inp
        sa = jnp.einsum('bhvk,bhk->bhv', state, -kk_t)
        state = (state * w_t[:, :, None, :]
                 + sa[..., None] * (kk_t * a_t)[:, :, None, :]
                 + v_t[..., None] * k_t[:, :, None, :])
        return state, jnp.einsum('bhvk,bhk->bhv', state, r_t)

    tm = lambda t: jnp.moveaxis(t, 1, 0)
    s0 = jnp.zeros((B_, N_RWKV_HEADS, HEAD_DIM, HEAD_DIM), jnp.float32)
    _, o = lax.scan(step, s0, (tm(r), tm(decay), tm(k), tm(v), tm(kk), tm(a)))
    o = jnp.moveaxis(o, 0, 1)
    mean = jnp.mean(o, axis=-1, keepdims=True)
    var = jnp.mean(jnp.square(o - mean), axis=-1, keepdims=True)
    o = ((o - mean) * lax.rsqrt(var + LNX_EPS)).reshape(B_, S_, D_RWKV) * lnx_w + lnx_b
    bonus = jnp.sum(r * k * r_k, axis=-1, keepdims=True) * v
    o = o + bonus.reshape(B_, S_, D_RWKV)
    return o * jax.nn.silu(g)


def t5_bucket(dist):
    n = jnp.maximum(dist, 0)
    nf = jnp.maximum(n, 1).astype(jnp.float32)
    large = MAX_EXACT + (jnp.log(nf / MAX_EXACT) / math.log(MAX_DISTANCE / MAX_EXACT)
                         * (N_BUCKETS - MAX_EXACT)).astype(jnp.int32)
    large = jnp.minimum(large, N_BUCKETS - 1)
    return jnp.where(n < MAX_EXACT, n, large)


def swa_sink_mixer(z, q_norm_w, k_norm_w, sinks, rel_bias):
    B_, S_ = z.shape[0], z.shape[1]
    nb = S_ // BLOCK
    q, k, v, g = jnp.split(z, ATT_SPLITS, axis=-1)
    q = rms_norm(q.reshape(B_, S_, N_Q_HEADS, HEAD_DIM), q_norm_w, NORM_EPS)
    k = rms_norm(k.reshape(B_, S_, N_KV_HEADS, HEAD_DIM), k_norm_w, NORM_EPS)
    v = v.reshape(B_, S_, N_KV_HEADS, HEAD_DIM)
    qb = q.reshape(B_, nb, BLOCK, N_KV_HEADS, KV_GROUP, HEAD_DIM)

    def band(t):
        tb = t.reshape(B_, nb, BLOCK, N_KV_HEADS, HEAD_DIM)
        prev = jnp.pad(tb, ((0, 0), (1, 0), (0, 0), (0, 0), (0, 0)))[:, :-1]
        return jnp.concatenate([prev, tb], axis=2)

    kb, vb = band(k), band(v)
    logits = jnp.einsum('bnqhgd,bnkhd->bnhgqk', qb, kb) * (HEAD_DIM ** -0.5)
    qi = jnp.arange(BLOCK)[:, None]
    kj = jnp.arange(2 * BLOCK)[None, :]
    dist = BLOCK + qi - kj
    bias = rel_bias.astype(jnp.float32)[t5_bucket(dist)]
    bias = jnp.transpose(bias, (2, 0, 1)).reshape(N_KV_HEADS, KV_GROUP, BLOCK, 2 * BLOCK)
    kpos = (jnp.arange(nb)[:, None, None] - 1) * BLOCK + kj[None]
    mask = (dist >= 0) & (dist < WINDOW) & (kpos >= 0)
    logits = jnp.where(mask[None, :, None, None], logits + bias, -jnp.inf)
    sink = sinks.astype(jnp.float32).reshape(1, 1, N_KV_HEADS, KV_GROUP, 1, 1)
    m = jnp.maximum(jnp.max(logits, axis=-1, keepdims=True), sink)
    e = jnp.exp(logits - m)
    p = e / (jnp.sum(e, axis=-1, keepdims=True) + jnp.exp(sink - m))
    o = jnp.einsum('bnhgqk,bnkhd->bnqhgd', p, vb).reshape(B_, S_, D_ATT)
    return o * jax.nn.silu(g)


def setup_inputs(seed: int = 0) -> dict:
    key = jax.random.key(seed)
    ks = jax.random.split(key, 20)
    f32 = jnp.float32
    nrm = lambda k, shape, s: jax.random.normal(k, shape, f32) * s
    L = DEPTH
    return {
        "x": jax.random.normal(ks[0], (BATCH, SEQ, D_MODEL), f32),
        "norm_w": 1.0 + nrm(ks[1], (L, D_MODEL), 0.02),
        "w_in": nrm(ks[2], (L, D_MODEL, D_IN), D_MODEL ** -0.5),
        "w_out": nrm(ks[3], (L, D_MIX, D_MODEL), D_MIX ** -0.5),
        "mu_rwkv": jax.random.uniform(ks[4], (L, RWKV_COLS), f32, 0.0, 1.0),
        "w0": jax.random.uniform(ks[5], (L, D_RWKV), f32, -6.0, 0.0),
        "w2": nrm(ks[6], (L, DECAY_LORA, D_RWKV), 0.1),
        "a0": nrm(ks[7], (L, D_RWKV), 0.5),
        "a2": nrm(ks[8], (L, AAA_LORA, D_RWKV), 0.5 * AAA_LORA ** -0.5),
        "k_k": 0.85 + nrm(ks[9], (L, D_RWKV), 0.05),
        "k_a": 1.0 + nrm(ks[10], (L, D_RWKV), 0.05),
        "r_k": nrm(ks[11], (L, N_RWKV_HEADS, HEAD_DIM), 0.1),
        "lnx_w": 1.0 + nrm(ks[12], (L, D_RWKV), 0.02),
        "lnx_b": nrm(ks[13], (L, D_RWKV), 0.02),
        "q_norm_w": 1.0 + nrm(ks[14], (L, HEAD_DIM), 0.02),
        "k_norm_w": 1.0 + nrm(ks[15], (L, HEAD_DIM), 0.02),
        "sinks": nrm(ks[16], (L, N_Q_HEADS), 0.5),
        "rel_bias": nrm(ks[17], (N_BUCKETS, N_Q_HEADS), 0.2),
    }


def reference(x, norm_w, w_in, w_out, mu_rwkv, w0, w2, a0, a2, k_k, k_a, r_k,
              lnx_w, lnx_b, q_norm_w, k_norm_w, sinks, rel_bias):
    for l in range(DEPTH):
        h = rms_norm(x, norm_w[l], NORM_EPS).astype(x.dtype)
        z = (h @ w_in[l]).astype(jnp.float32)
        y_rwkv = rwkv7_mixer(z[..., :RWKV_COLS], mu_rwkv[l], w0[l], w2[l], a0[l], a2[l],
                             k_k[l], k_a[l], r_k[l], lnx_w[l], lnx_b[l])
        y_att = swa_sink_mixer(z[..., RWKV_COLS:], q_norm_w[l], k_norm_w[l], sinks[l], rel_bias)
        y = jnp.concatenate([y_rwkv, y_att], axis=-1).astype(x.dtype)
        x = x + y @ w_out[l]
    return x
```

```cpp
#include <hip/hip_runtime.h>
#include <cstdio>
#include <cstdint>
namespace pg8 {
#define PG8_LAS __attribute__((address_space(3)))
typedef unsigned short bf16_t;
typedef short bf16x8 __attribute__((ext_vector_type(8)));
typedef float f32x4 __attribute__((ext_vector_type(4)));
typedef unsigned u32x4 __attribute__((ext_vector_type(4)));
constexpr int BM = 256, BK = 64, HALF = 128, HTB = HALF * BK * 2  , STAGE_BYTES = 8 * HTB, NXCD = 8, WGM = 8;

__host__ __device__ __forceinline__ int lds_byte(int r, int c) { const int st = (r >> 4) * 2 + (c >> 5), rr = r & 15, cc = c & 31, ob = rr * 64 + cc * 2; return st * 1024 + (ob ^ (((ob >> 9) & 1) << 5)); }
__host__ __device__ __forceinline__ void stage_rc(int b, int& R, int& C) { const int st = b / 1024, sb = b % 1024, swz = sb ^ (((sb >> 9) & 1) << 5); R = (st >> 1) * 16 + swz / 64; C = (st & 1) * 32 + (swz % 64) / 2; }
__host__ __device__ __forceinline__ int perm32(int rho) { const int n = rho >> 4, i = rho & 15; return 8 * (i >> 2) + 4 * n + (i & 3); }

struct Unit { int pm, pn; };
struct Gemm { const bf16_t* A; const bf16_t* Bt; int M, N, K; };

struct StaticOrder {
    int nM, nN, nwg, G, c;
    __host__ __device__ void init(int M, int N, int G_, int c_) { nM = M / BM; nN = N / BM; nwg = nM * nN; G = G_; c = c_; }
    __host__ __device__ bool next(int i, Unit& u) const {
        const long L = (long)i * G + c; if (L >= nwg) return false;
        int wgid = (int)L; { const int q = nwg / NXCD, r = nwg % NXCD, xcd = wgid % NXCD, off = wgid / NXCD; wgid = (xcd < r ? xcd * (q + 1) : r * (q + 1) + (xcd - r) * q) + off; }
        const int nig = WGM * nN, gid = wgid / nig, fm = gid * WGM, gsz = (nM - fm) < WGM ? (nM - fm) : WGM;
        u.pm = fm + ((wgid % nig) % gsz); u.pn = (wgid % nig) / gsz; return true;
    }
    __device__ __forceinline__ void a_ready(const Unit&) const {}
    __device__ __forceinline__ void done(const Unit&) const {}
};

__device__ __forceinline__ unsigned cvt_pk_bf16(float lo, float hi) { unsigned r; asm volatile("v_cvt_pk_bf16_f32 %0, %1, %2" : "=v"(r) : "v"(lo), "v"(hi)); return r; }
typedef float f32x2 __attribute__((ext_vector_type(2)));

struct EpiBf16 {
    static constexpr bool PERM = true, AFTER_DRAIN = false;
    bf16_t* O; int ldc;
    __device__ __forceinline__ void operator()(const f32x4 (&acc)[2][2][4][2], const Unit& u, int wr, int wc, int fr, int fq) const {
        const int row0 = u.pm * BM + wr * 64 + fr; const int col0 = u.pn * BM + wc * 32 + 8 * fq;
#pragma unroll
        for (int ai = 0; ai < 2; ++ai)
#pragma unroll
            for (int m = 0; m < 4; ++m) { bf16_t* rowp = O + (size_t)(row0 + ai * HALF + m * 16) * ldc + col0;
#pragma unroll
                for (int bj = 0; bj < 2; ++bj) { const f32x4 v0 = acc[ai][bj][m][0], v1 = acc[ai][bj][m][1];
                    u32x4 w; w.x = cvt_pk_bf16(v0[0], v0[1]); w.y = cvt_pk_bf16(v0[2], v0[3]); w.z = cvt_pk_bf16(v1[0], v1[1]); w.w = cvt_pk_bf16(v1[2], v1[3]);
                    *(u32x4*)(rowp + bj * HALF) = w; } }
    }
};
struct EpiResF32 {
    static constexpr bool PERM = false, AFTER_DRAIN = false;
    const float* base; float* out; int ldc;
    __device__ __forceinline__ void operator()(const f32x4 (&acc)[2][2][4][2], const Unit& u, int wr, int wc, int fr, int fq) const {
        const int row0 = u.pm * BM + wr * 64 + fr; const int col0 = u.pn * BM + wc * 32 + 4 * fq;
#pragma unroll
        for (int ai = 0; ai < 2; ++ai)
#pragma unroll
            for (int m = 0; m < 4; ++m) { const size_t off = (size_t)(row0 + ai * HALF + m * 16) * ldc + col0;
#pragma unroll
                for (int bj = 0; bj < 2; ++bj)
#pragma unroll
                    for (int n = 0; n < 2; ++n) { const f32x4 bs = *(const f32x4*)(base + off + bj * HALF + n * 16); *(f32x4*)(out + off + bj * HALF + n * 16) = bs + acc[ai][bj][m][n]; } }
    }
};
template <class Epi, class Sched, bool ALIGN_EPI = false, bool SP2 = false>
__device__ __forceinline__ void gemm_phase(PG8_LAS unsigned char* lds, const Gemm g, const Sched& S, const Epi& E) {
    const int tid = threadIdx.x, wid = __builtin_amdgcn_readfirstlane(tid >> 6), lane = tid & 63, wr = wid >> 2, wc = wid & 3, fr = lane & 15, fq = lane >> 4;
    const int K = g.K, nt = K / BK;
    unsigned voffA[2], voffB[2];
#pragma unroll
    for (int i = 0; i < 2; ++i) { int R, C; stage_rc(tid * 16 + i * 8192, R, C); const int Rb = Epi::PERM ? ((R & ~31) + perm32(R & 31)) : R;
        voffA[i] = (unsigned)(R * K + C) * 2u; voffB[i] = (unsigned)(Rb * K + C) * 2u; }
    const size_t kstep = (size_t)(BK * 2);
    const size_t hstep = (size_t)HALF * K * 2;
    const size_t tstep = 2 * hstep;
    const unsigned ldsw = (unsigned)wid * 1024u;
    const int aoff = lds_byte(wr * 64 + fr, fq * 8), boff = lds_byte(wc * 32 + fr, fq * 8);
#define PG8_SA(b, h) (((b) * 2 + (h)) * HTB)
#define PG8_SB(b, h) ((4 + (b) * 2 + (h)) * HTB)
#define PG8_STAGE(bufoff, gbase, voff) do { _Pragma("unroll") for (int _i = 0; _i < 2; ++_i) \
        __builtin_amdgcn_global_load_lds((const unsigned*)((const char*)(gbase) + (voff)[_i]), (PG8_LAS unsigned*)(lds + (bufoff) + ldsw + _i * 8192), 16, 0, 0); } while (0)
#define PG8_LDA(dst, b, h) do { _Pragma("unroll") for (int m = 0; m < 4; ++m) _Pragma("unroll") for (int k = 0; k < 2; ++k) dst[m][k] = *(const PG8_LAS bf16x8*)(lds + PG8_SA(b, h) + aoff + m * 2048 + k * 1024); } while (0)
#define PG8_LDB(dst, b, h) do { _Pragma("unroll") for (int n = 0; n < 2; ++n) _Pragma("unroll") for (int k = 0; k < 2; ++k) dst[n][k] = *(const PG8_LAS bf16x8*)(lds + PG8_SB(b, h) + boff + n * 2048 + k * 1024); } while (0)
#define PG8_MMA(ai, bj, At, Bt) do { __builtin_amdgcn_s_setprio(1); _Pragma("unroll") for (int m = 0; m < 4; ++m) _Pragma("unroll") for (int n = 0; n < 2; ++n) _Pragma("unroll") for (int k = 0; k < 2; ++k) \
        acc[ai][bj][m][n] = __builtin_amdgcn_mfma_f32_16x16x32_bf16(Bt[n][k], At[m][k], acc[ai][bj][m][n], 0, 0, 0); __builtin_amdgcn_s_setprio(0); } while (0)
#define PG8_WAIT_V(n) asm volatile("s_waitcnt vmcnt(" #n ")" ::: "memory")
#define PG8_WAIT_L(n) asm volatile("s_waitcnt lgkmcnt(" #n ")" ::: "memory")
#define PG8_BAR __builtin_amdgcn_s_barrier()
#define PG8_SCHED __builtin_amdgcn_sched_barrier(0)
    Unit cur, nxt; int ui = 0;
    if (!S.next(0, cur)) return;
    f32x4 acc[2][2][4][2];
#pragma unroll
    for (int a = 0; a < 2; ++a)
#pragma unroll
        for (int b = 0; b < 2; ++b)
#pragma unroll
            for (int m = 0; m < 4; ++m)
#pragma unroll
                for (int n = 0; n < 2; ++n) acc[a][b][m][n] = (f32x4){0.f, 0.f, 0.f, 0.f};
    bf16x8 At[4][2], B0[2][2], B1[2][2];
    const char* cA = (const char*)g.A + (size_t)cur.pm * tstep; const char* cB = (const char*)g.Bt + (size_t)cur.pn * tstep;
    S.a_ready(cur);
    if constexpr (SP2) {
        PG8_STAGE(PG8_SB(0, 0), cB, voffB); PG8_STAGE(PG8_SB(0, 1), cB + hstep, voffB); PG8_STAGE(PG8_SA(0, 0), cA, voffA); PG8_STAGE(PG8_SA(0, 1), cA + hstep, voffA);
        if (wr == 1) PG8_BAR;
        PG8_WAIT_V(2); PG8_BAR;
        PG8_STAGE(PG8_SB(1, 0), cB + kstep, voffB); PG8_STAGE(PG8_SA(1, 0), cA + kstep, voffA); PG8_STAGE(PG8_SB(1, 1), cB + hstep + kstep, voffB);
        PG8_WAIT_V(6); PG8_BAR;
    } else {
        PG8_STAGE(PG8_SB(0, 0), cB, voffB); PG8_STAGE(PG8_SA(0, 0), cA, voffA); PG8_STAGE(PG8_SB(0, 1), cB + hstep, voffB); PG8_STAGE(PG8_SA(0, 1), cA + hstep, voffA);
        if (wr == 1) PG8_BAR;
        PG8_WAIT_V(4); PG8_BAR;
        PG8_STAGE(PG8_SB(1, 0), cB + kstep, voffB); PG8_STAGE(PG8_SA(1, 0), cA + kstep, voffA); PG8_STAGE(PG8_SB(1, 1), cB + hstep + kstep, voffB);
        PG8_WAIT_V(6); PG8_BAR;
    }
    for (;;) {
        const bool has_next = S.next(ui + 1, nxt);
        const char* nA = has_next ? (const char*)g.A + (size_t)nxt.pm * tstep : cA; const char* nB = has_next ? (const char*)g.Bt + (size_t)nxt.pn * tstep : cB;
        for (int t = 0; t < nt; t += 2) {
            const bool last = (t == nt - 2);
            const char* a1 = cA + (size_t)(t + 1) * kstep;
            const char* a2 = last ? nA : cA + (size_t)(t + 2) * kstep; const char* b2 = last ? nB : cB + (size_t)(t + 2) * kstep;
            const char* a3 = a2 + kstep; const char* b3 = b2 + kstep;
            if (last && has_next) S.a_ready(nxt);
            if constexpr (SP2) {
            PG8_LDB(B0, 0, 0); PG8_LDB(B1, 0, 1); PG8_SCHED; PG8_LDA(At, 0, 0); PG8_STAGE(PG8_SA(1, 1), a1 + hstep, voffA);
            PG8_WAIT_V(8); PG8_WAIT_L(0); PG8_BAR; PG8_MMA(0, 0, At, B0); PG8_MMA(0, 1, At, B1); PG8_BAR; PG8_SCHED;
            PG8_LDA(At, 0, 1); PG8_STAGE(PG8_SB(0, 0), b2, voffB); PG8_STAGE(PG8_SB(0, 1), b2 + hstep, voffB); PG8_STAGE(PG8_SA(0, 0), a2, voffA);
            PG8_WAIT_V(8); PG8_WAIT_L(0); PG8_BAR; PG8_MMA(1, 0, At, B0); PG8_MMA(1, 1, At, B1); PG8_BAR; PG8_SCHED;
            PG8_LDB(B0, 1, 0); PG8_LDB(B1, 1, 1); PG8_SCHED; PG8_LDA(At, 1, 0); PG8_STAGE(PG8_SA(0, 1), a2 + hstep, voffA);
            PG8_WAIT_V(8); PG8_WAIT_L(0); PG8_BAR; PG8_MMA(0, 0, At, B0); PG8_MMA(0, 1, At, B1); PG8_BAR; PG8_SCHED;
            PG8_LDA(At, 1, 1); PG8_STAGE(PG8_SB(1, 0), b3, voffB); PG8_STAGE(PG8_SB(1, 1), b3 + hstep, voffB); PG8_STAGE(PG8_SA(1, 0), a3, voffA);
            PG8_WAIT_V(8); PG8_WAIT_L(0); PG8_BAR; PG8_MMA(1, 0, At, B0); PG8_MMA(1, 1, At, B1); PG8_BAR; PG8_SCHED;
            } else {
            PG8_LDB(B0, 0, 0); PG8_SCHED; PG8_LDA(At, 0, 0); PG8_STAGE(PG8_SA(1, 1), a1 + hstep, voffA);
            PG8_WAIT_L(8); PG8_BAR; PG8_WAIT_L(0); PG8_MMA(0, 0, At, B0); PG8_BAR; PG8_SCHED;
            PG8_LDB(B1, 0, 1); PG8_STAGE(PG8_SB(0, 0), b2, voffB);
            PG8_BAR; PG8_WAIT_L(0); PG8_MMA(0, 1, At, B1); PG8_BAR;
            PG8_LDA(At, 0, 1); PG8_STAGE(PG8_SA(0, 0), a2, voffA);
            PG8_BAR; PG8_WAIT_L(0); PG8_MMA(1, 0, At, B0); PG8_BAR; PG8_SCHED;
            PG8_STAGE(PG8_SB(0, 1), b2 + hstep, voffB);
            PG8_WAIT_V(6); PG8_BAR; PG8_MMA(1, 1, At, B1); PG8_BAR;
            PG8_LDB(B0, 1, 0); PG8_SCHED; PG8_LDA(At, 1, 0); PG8_STAGE(PG8_SA(0, 1), a2 + hstep, voffA);
            PG8_WAIT_L(8); PG8_BAR; PG8_WAIT_L(0); PG8_MMA(0, 0, At, B0); PG8_BAR; PG8_SCHED;
            PG8_LDB(B1, 1, 1); PG8_STAGE(PG8_SB(1, 0), b3, voffB);
            PG8_BAR; PG8_WAIT_L(0); PG8_MMA(0, 1, At, B1); PG8_BAR;
            PG8_LDA(At, 1, 1); PG8_STAGE(PG8_SA(1, 0), a3, voffA);
            PG8_BAR; PG8_WAIT_L(0); PG8_MMA(1, 0, At, B0); PG8_BAR; PG8_SCHED;
            PG8_STAGE(PG8_SB(1, 1), b3 + hstep, voffB);
            PG8_WAIT_V(6); PG8_BAR; PG8_MMA(1, 1, At, B1); PG8_BAR;
            }
        }
        if constexpr (ALIGN_EPI) { if (wr == 0) PG8_BAR; }
        if constexpr (!Epi::AFTER_DRAIN) { E(acc, cur, wr, wc, fr, fq); S.done(cur); }
        if (!has_next) break;
#pragma unroll
        for (int a = 0; a < 2; ++a)
#pragma unroll
            for (int b = 0; b < 2; ++b)
#pragma unroll
                for (int m = 0; m < 4; ++m)
#pragma unroll
                    for (int n = 0; n < 2; ++n) acc[a][b][m][n] = (f32x4){0.f, 0.f, 0.f, 0.f};
        cur = nxt; cA = nA; cB = nB; ++ui;
        if constexpr (ALIGN_EPI) { if (wr == 1) PG8_BAR; }
    }
    PG8_WAIT_V(0);
    if constexpr (!ALIGN_EPI) { if (wr == 0) PG8_BAR; }
    PG8_BAR;
    if constexpr (Epi::AFTER_DRAIN) { E.fused(acc, cur, wr, wc, fr, fq, lds, wid, lane); S.done(cur); }
#undef PG8_SA
#undef PG8_SB
#undef PG8_STAGE
#undef PG8_LDA
#undef PG8_LDB
#undef PG8_MMA
#undef PG8_WAIT_V
#undef PG8_WAIT_L
#undef PG8_BAR
#undef PG8_SCHED
}
}

#define GAS __attribute__((address_space(1)))
#define LAS __attribute__((address_space(3)))
typedef unsigned short bf16;
typedef unsigned v4u __attribute__((ext_vector_type(4)));
typedef float f32x4 __attribute__((ext_vector_type(4)));
typedef short bf16x8 __attribute__((ext_vector_type(8)));
typedef GAS unsigned gu32;
typedef GAS unsigned long long gu64;
#define RLX_AGENT __ATOMIC_RELAXED, __HIP_MEMORY_SCOPE_AGENT
#define LDS_WAIT() asm volatile("s_waitcnt lgkmcnt(0)" ::: "memory")
#define VM_WAIT() asm volatile("s_waitcnt vmcnt(0)" ::: "memory")
__device__ __forceinline__ unsigned long long rt() { return __builtin_amdgcn_s_memrealtime(); }
__device__ __forceinline__ unsigned f2bf(float f) { unsigned u = __builtin_bit_cast(unsigned, f); return (u + 0x7fffu + ((u >> 16) & 1u)) >> 16; }
__device__ __forceinline__ unsigned pk2(float lo, float hi) { return f2bf(lo) | (f2bf(hi) << 16); }


#define XB_TMO      128
#define XB_XCNT(j)  (256  + 64 * (j))
#define XB_XSUB(j)  (1280 + 64 * (j))
#define XB_XGEN(j)  (2304 + 64 * (j))
#define XB_TOP      3328
#define XB_TOPGEN   3392
#define XCD_BAR_WORDS 3456
#define XB_SPIN_CAP (1u << 18)

__device__ __forceinline__ unsigned xb_ld(unsigned* p)              { return __hip_atomic_load(p, __ATOMIC_RELAXED, __HIP_MEMORY_SCOPE_AGENT); }
__device__ __forceinline__ unsigned xb_add(unsigned* p, unsigned v) { return __hip_atomic_fetch_add(p, v, __ATOMIC_RELAXED, __HIP_MEMORY_SCOPE_AGENT); }
__device__ __forceinline__ unsigned xb_xcc_id() { return (unsigned)__builtin_amdgcn_s_getreg((3 << 11) | 20) & 0xFu; }
#define XB_SPIN(cond, bar) do { unsigned _sp = 0; while (cond) { __builtin_amdgcn_s_sleep(1); \
    if ((++_sp & 255u) == 0u) { if (xb_ld(&(bar)[XB_TMO])) break; if (_sp > XB_SPIN_CAP) { atomicAdd(&(bar)[XB_TMO], 1u); break; } } } } while (0)

struct XcdBarrier {
    unsigned* bar; unsigned x;
    volatile LAS unsigned* st;
};

__device__ __forceinline__ XcdBarrier xcd_barrier_post(unsigned* bar, volatile LAS unsigned* st) {
    XcdBarrier b; b.bar = bar; b.x = xb_xcc_id(); b.st = st;
    if (threadIdx.x == 0) (void)xb_add(&bar[XB_XCNT(b.x)], 1u);
    return b;
}
__device__ __forceinline__ void xcd_barrier_complete(unsigned* bar, unsigned x, unsigned& nloc, unsigned& nx) {
    const unsigned G = gridDim.x * gridDim.y * gridDim.z;
    unsigned sum, cnt, mine, sp = 0u;
    for (;;) {
        sum = 0u; cnt = 0u; mine = 0u;
#pragma unroll
        for (unsigned j = 0; j < 16; ++j) { const unsigned c = xb_ld(&bar[XB_XCNT(j)]); sum += c; cnt += (c > 0u) ? 1u : 0u; mine = (j == x) ? c : mine; }
        if (sum == G) break;
        __builtin_amdgcn_s_sleep(1);
        if ((++sp & 255u) == 0u) { if (xb_ld(&bar[XB_TMO])) break; if (sp > XB_SPIN_CAP) { atomicAdd(&bar[XB_TMO], 1u); break; } }
    }
    nloc = mine > 0u ? mine : 1u; nx = cnt > 0u ? cnt : 1u;
}

__device__ __forceinline__ void xcd_barrier(const XcdBarrier& b) {
    asm volatile("s_waitcnt vmcnt(0)" ::: "memory");
    __syncthreads();
    if (threadIdx.x == 0) {
        unsigned* bar = b.bar;
        __builtin_amdgcn_s_waitcnt(0);
        unsigned nloc = b.st[0], nx = b.st[1];
        if (nloc == 0u) { xcd_barrier_complete(bar, b.x, nloc, nx); b.st[0] = nloc; b.st[1] = nx; }
        const unsigned old = xb_add(&bar[XB_XSUB(b.x)], 1u);
        const unsigned gen = old / nloc;
        if (old + 1u == (gen + 1u) * nloc) {
            __builtin_amdgcn_fence(__ATOMIC_RELEASE, "agent");
            asm volatile("s_waitcnt vmcnt(0)" ::: "memory");
            const unsigned og = xb_add(&bar[XB_TOP], 1u);
            const unsigned tg = og / nx;
            if (og + 1u == (tg + 1u) * nx) xb_add(&bar[XB_TOPGEN], 1u);
            else XB_SPIN(xb_ld(&bar[XB_TOPGEN]) == tg, bar);
            __builtin_amdgcn_fence(__ATOMIC_ACQUIRE, "agent");
            xb_add(&bar[XB_XGEN(b.x)], 1u);
            asm volatile("s_waitcnt vmcnt(0)" ::: "memory");
        } else {
            XB_SPIN(xb_ld(&bar[XB_XGEN(b.x)]) == gen, bar);
            __builtin_amdgcn_fence(__ATOMIC_ACQUIRE, "agent");
            asm volatile("s_waitcnt vmcnt(0)" ::: "memory");
        }
    }
    __syncthreads();
}

constexpr int NWAVES = 8, NTHR = 512;
constexpr int SEQ = 8192, DM = 2048, DIN = 6528, NPAD = 6656, ZLD = 6656;
constexpr int C_R = 0, C_K = 1024, C_V = 2048, C_G = 3072, C_WL = 4096, C_AL = 4160, C_Q = 4224, C_AK = 5248, C_AV = 5376, C_AG = 5504;
constexpr int NH = 16, HD = 64, DR = 1024;
#ifndef MK_FUSED
#define MK_FUSED 0
#endif
constexpr int N_PHASES = 6;
constexpr size_t MiB = 1u << 20;
constexpr size_t WS_CTL = 0, CTL_ZERO_BYTES = 1 * MiB;
constexpr size_t WS_WTOUT = 1 * MiB;
constexpr size_t WS_Z = 9 * MiB;
constexpr size_t WS_H = 113 * MiB;
constexpr size_t WS_WTIN = 145 * MiB;
constexpr size_t WS_RR = 145 * MiB, WS_KR = 161 * MiB, WS_VV = 177 * MiB, WS_AL = 193 * MiB;
constexpr size_t WS_LOGD = 209 * MiB;
constexpr size_t WS_VT = 241 * MiB;
constexpr size_t WS_RS = 243 * MiB;
constexpr size_t WS_END = 256 * MiB;
constexpr int CW_BAR = 4096;
constexpr int RING_BYTES = 131072, LDSCTL_OFF = RING_BYTES, MISC_OFF = LDSCTL_OFF + 320, LDS_BYTES = 147456;

struct Frame {
    LAS unsigned char* lds;
    volatile LAS unsigned* MISC;
    gu32* ctl;
    int tid, lane, wave, vcu, G;
};
struct Args { const float* in[18]; float* out; unsigned char* ws; int ph_lo, ph_hi; };

__device__ __forceinline__ float wave_sum(float v) {
#pragma unroll
    for (int o = 1; o < 64; o <<= 1) v += __shfl_xor(v, o);
    return v;
}
__device__ __forceinline__ float bf2f(bf16 b) { return __builtin_bit_cast(float, (unsigned)b << 16); }
__device__ __forceinline__ float bflo(unsigned w) { return __builtin_bit_cast(float, w << 16); }
__device__ __forceinline__ float bfhi(unsigned w) { return __builtin_bit_cast(float, w & 0xffff0000u); }

__device__ __forceinline__ void p0_transpose_item(const float* W, int K, int N, bf16* WT, LAS float* scr, int item, int lane) {
    const int nblk = N / 32, kb = item / nblk, nb = item % nblk, k0 = 64 * kb, n0 = 32 * nb;
#pragma unroll 8
    for (int i = 0; i < 32; ++i) { const int kk = 2 * i + (lane >> 5); scr[kk * 33 + (lane & 31)] = W[(size_t)(k0 + kk) * N + n0 + (lane & 31)]; }
    LDS_WAIT(); asm volatile("" ::: "memory");
    const int c = lane & 7;
#pragma unroll
    for (int j = 0; j < 4; ++j) { const int n = (lane >> 3) + 8 * j; const LAS float* s = scr + (8 * c) * 33 + n;
        v4u o; o.x = pk2(s[0 * 33], s[1 * 33]); o.y = pk2(s[2 * 33], s[3 * 33]); o.z = pk2(s[4 * 33], s[5 * 33]); o.w = pk2(s[6 * 33], s[7 * 33]);
        *(GAS v4u*)(WT + (size_t)(n0 + n) * K + k0 + 8 * c) = o; }
    LDS_WAIT(); asm volatile("" ::: "memory");
}

__device__ __forceinline__ void p0_prologue(Frame& F, const Args& a, unsigned char* ws) {
    const float* x = a.in[0]; const float* norm_w = a.in[1]; const float* w_in = a.in[2]; const float* w_out = a.in[3];
    bf16* WTIN = (bf16*)(ws + WS_WTIN); bf16* WTOUT = (bf16*)(ws + WS_WTOUT); bf16* H = (bf16*)(ws + WS_H);
    LAS float* scr = (LAS float*)(F.lds + F.wave * 16384);
    const int gw = F.vcu * NWAVES + F.wave, NGW = F.G * NWAVES;
    constexpr int I_IN = (DM / 64) * (DIN / 32), I_OUT = (DM / 64) * (DM / 32);
    for (int it = gw; it < I_IN + I_OUT; it += NGW) {
        if (it < I_IN) p0_transpose_item(w_in, DM, DIN, WTIN, scr, it, F.lane);
        else p0_transpose_item(w_out, DM, DM, WTOUT, scr, it - I_IN, F.lane);
    }
    { GAS v4u* p = (GAS v4u*)(WTIN + (size_t)DIN * DM); const int n16 = (NPAD - DIN) * DM * 2 / 16;
      for (int i = blockIdx.x * NTHR + F.tid; i < n16; i += F.G * NTHR) p[i] = (v4u){0u, 0u, 0u, 0u}; }
    for (int m = gw; m < SEQ; m += NGW) {
        const GAS f32x4* xr = (const GAS f32x4*)(x + (size_t)m * DM) + F.lane;
        f32x4 v[8]; float s = 0.f;
#pragma unroll
        for (int j = 0; j < 8; ++j) { v[j] = xr[64 * j]; s += (v[j].x * v[j].x + v[j].y * v[j].y) + (v[j].z * v[j].z + v[j].w * v[j].w); }
        const float rstd = 1.0f / sqrtf(wave_sum(s) * (1.f / DM) + 1e-6f);
        GAS unsigned long long* o8 = (GAS unsigned long long*)(H + (size_t)m * DM) + F.lane;
        const GAS f32x4* nw = (const GAS f32x4*)norm_w + F.lane;
#pragma unroll
        for (int j = 0; j < 8; ++j) { const f32x4 g = nw[64 * j];
            o8[64 * j] = (unsigned long long)pk2(v[j].x * rstd * g.x, v[j].y * rstd * g.y) | ((unsigned long long)pk2(v[j].z * rstd * g.z, v[j].w * rstd * g.w) << 32); }
    }
}

__device__ __forceinline__ float zshift(const bf16* Z, int t, int col, float mu) {
    const float zc = bf2f(Z[(size_t)t * ZLD + col]); const float zp = t > 0 ? bf2f(Z[(size_t)(t - 1) * ZLD + col]) : 0.f;
    return zc + (zp - zc) * mu;
}
__device__ __forceinline__ void p2_prep(Frame& F, const Args& a, unsigned char* ws) {
    bf16* Z = (bf16*)(ws + WS_Z);
    bf16* RR = (bf16*)(ws + WS_RR); bf16* KR = (bf16*)(ws + WS_KR); bf16* VV = (bf16*)(ws + WS_VV); bf16* AL = (bf16*)(ws + WS_AL);
    float* LOGD = (float*)(ws + WS_LOGD); bf16* VT = (bf16*)(ws + WS_VT); float* RS = (float*)(ws + WS_RS);
    const float* mu = a.in[4]; const float* w0 = a.in[5]; const float* w2 = a.in[6]; const float* a0 = a.in[7]; const float* a2 = a.in[8];
    const float* k_k = a.in[9]; const float* qnw = a.in[14]; const float* knw = a.in[15];
    LAS float* th = (LAS float*)F.lds;
    LAS float* alv = th + 512;
    const int tid = F.tid, lane = F.lane, wave = F.wave;
    for (int it = blockIdx.x; it < SEQ / 8; it += F.G) {
        const int t0 = it * 8;
        __syncthreads();
        { const int tok = tid >> 6, j = tid & 63, t = t0 + tok;
          th[tok * 64 + j] = tanhf(zshift(Z, t, C_WL + j, mu[C_WL + j]));
          alv[tok * 64 + j] = zshift(Z, t, C_AL + j, mu[C_AL + j]); }
        __syncthreads();
        { float accw[2][8], acca[2][8];
#pragma unroll
          for (int c = 0; c < 2; ++c)
#pragma unroll
              for (int k = 0; k < 8; ++k) { accw[c][k] = 0.f; acca[c][k] = 0.f; }
          for (int j = 0; j < 64; ++j) {
              const float w2a = w2[j * DR + tid], w2b = w2[j * DR + tid + 512], a2a = a2[j * DR + tid], a2b = a2[j * DR + tid + 512];
#pragma unroll
              for (int k = 0; k < 8; ++k) { const float tv = th[k * 64 + j], av = alv[k * 64 + j];
                  accw[0][k] += tv * w2a; accw[1][k] += tv * w2b; acca[0][k] += av * a2a; acca[1][k] += av * a2b; }
          }
#pragma unroll
          for (int c = 0; c < 2; ++c) { const int ch = tid + 512 * c; const float w0c = w0[ch], a0c = a0[ch];
#pragma unroll
              for (int k = 0; k < 8; ++k) {
                  const float nx = -(w0c + accw[c][k]);
                  const float sp = nx > 20.f ? nx : log1pf(expf(nx));
                  const float wv = -sp - 0.5f;
                  LOGD[(size_t)(t0 + k) * DR + ch] = -expf(wv);
                  const float alr = 1.f / (1.f + expf(-(a0c + acca[c][k])));
                  AL[(size_t)(t0 + k) * DR + ch] = (bf16)f2bf(alr);
              } }
        }
        for (int item = tid; item < 8 * 384; item += NTHR) {
            const int tok = item / 384, cv = item % 384, col = cv * 8, t = t0 + tok;
            const v4u zc = *(const v4u*)(Z + (size_t)t * ZLD + col);
            v4u zp = (v4u){0u, 0u, 0u, 0u}; if (t > 0) zp = *(const v4u*)(Z + (size_t)(t - 1) * ZLD + col);
            const f32x4 m0 = *(const f32x4*)(mu + col), m1 = *(const f32x4*)(mu + col + 4);
            float o[8];
            { float c_, p_;
              c_ = bflo(zc.x); p_ = bflo(zp.x); o[0] = c_ + (p_ - c_) * m0.x;  c_ = bfhi(zc.x); p_ = bfhi(zp.x); o[1] = c_ + (p_ - c_) * m0.y;
              c_ = bflo(zc.y); p_ = bflo(zp.y); o[2] = c_ + (p_ - c_) * m0.z;  c_ = bfhi(zc.y); p_ = bfhi(zp.y); o[3] = c_ + (p_ - c_) * m0.w;
              c_ = bflo(zc.z); p_ = bflo(zp.z); o[4] = c_ + (p_ - c_) * m1.x;  c_ = bfhi(zc.z); p_ = bfhi(zp.z); o[5] = c_ + (p_ - c_) * m1.y;
              c_ = bflo(zc.w); p_ = bflo(zp.w); o[6] = c_ + (p_ - c_) * m1.z;  c_ = bfhi(zc.w); p_ = bfhi(zp.w); o[7] = c_ + (p_ - c_) * m1.w; }
            v4u w; w.x = pk2(o[0], o[1]); w.y = pk2(o[2], o[3]); w.z = pk2(o[4], o[5]); w.w = pk2(o[6], o[7]);
            bf16* dst = (col < 1024) ? RR : (col < 2048 ? KR : VV);
            *(v4u*)(dst + (size_t)t * DR + (col & 1023)) = w;
        }
        for (int hv = wave; hv < 8 * 16; hv += NWAVES) {
            const int tok = hv >> 4, h = hv & 15, t = t0 + tok, ch = h * 64 + lane;
            const float kr = bf2f((bf16)f2bf(zshift(Z, t, C_K + ch, mu[C_K + ch])));
            const float kp = kr * k_k[ch];
            const float n2 = wave_sum(kp * kp);
            if (lane == 0) RS[(size_t)t * 16 + h] = 1.0f / sqrtf(fmaxf(n2, 1e-24f));
        }
        for (int hv = wave; hv < 8 * 18; hv += NWAVES) {
            const int tok = hv / 18, hh = hv % 18, t = t0 + tok;
            const int col = hh < 16 ? C_Q + hh * 64 : C_AK + (hh - 16) * 64;
            bf16* p = Z + (size_t)t * ZLD + col + lane;
            const float v = bf2f(*p);
            const float ss = wave_sum(v * v);
            const float rstd = 1.0f / sqrtf(ss * (1.f / 64.f) + 1e-6f);
            const float g = hh < 16 ? qnw[lane] * 0.125f : knw[lane];
            *p = (bf16)f2bf(v * rstd * g);
        }
        { const int dcol = tid & 127, tp = tid >> 7, t = t0 + 2 * tp;
          const unsigned lo = Z[(size_t)t * ZLD + C_AV + dcol], hi = Z[(size_t)(t + 1) * ZLD + C_AV + dcol];
          *(unsigned*)(VT + (size_t)dcol * SEQ + t) = lo | (hi << 16); }
    }
}

__device__ __forceinline__ void p3_scan(Frame& F, const Args& a, unsigned char* ws) {
    const bf16* RR = (const bf16*)(ws + WS_RR); const bf16* KR = (const bf16*)(ws + WS_KR); const bf16* VV = (const bf16*)(ws + WS_VV); const bf16* AL = (const bf16*)(ws + WS_AL);
    const float* LOGD = (const float*)(ws + WS_LOGD); const float* RS = (const float*)(ws + WS_RS);
    bf16* Z = (bf16*)(ws + WS_Z);
    const float* k_k = a.in[9]; const float* k_a = a.in[10];
    const int head = blockIdx.x >> 3, row = (blockIdx.x & 7) * 8 + F.wave, lane = F.lane;
    const int ch = head * 64 + lane;
    const float kkc = k_k[ch], kac = k_a[ch];
    float s = 0.f;
    constexpr int U = 4;
    float kr[U], al[U], rr[U], vr[U], ld[U], rs[U];
#pragma unroll
    for (int u = 0; u < U; ++u) { const size_t b = (size_t)u * DR; kr[u] = bf2f(KR[b + ch]); al[u] = bf2f(AL[b + ch]); rr[u] = bf2f(RR[b + ch]); vr[u] = bf2f(VV[b + head * 64 + row]); ld[u] = LOGD[b + ch]; rs[u] = RS[u * 16 + head]; }
    for (int t = 0; t < SEQ; t += U) {
        float nkr[U], nal[U], nrr[U], nvr[U], nld[U], nrs[U];
        const int tn = (t + U < SEQ) ? t + U : t;
#pragma unroll
        for (int u = 0; u < U; ++u) { const size_t b = (size_t)(tn + u) * DR; nkr[u] = bf2f(KR[b + ch]); nal[u] = bf2f(AL[b + ch]); nrr[u] = bf2f(RR[b + ch]); nvr[u] = bf2f(VV[b + head * 64 + row]); nld[u] = LOGD[b + ch]; nrs[u] = RS[(size_t)(tn + u) * 16 + head]; }
#pragma unroll
        for (int u = 0; u < U; ++u) {
            const float kk = kr[u] * kkc * rs[u];
            const float bb = kk * al[u];
            const float km = kr[u] * (1.f + (al[u] - 1.f) * kac);
            const float w = expf(ld[u]);
            const float sa = -wave_sum(s * kk);
            s = s * w + sa * bb + vr[u] * km;
            const float o = wave_sum(s * rr[u]);
            if (lane == 0) ((float*)(Z + (size_t)(t + u) * ZLD))[head * 64 + row] = o;
        }
#pragma unroll
        for (int u = 0; u < U; ++u) { kr[u] = nkr[u]; al[u] = nal[u]; rr[u] = nrr[u]; vr[u] = nvr[u]; ld[u] = nld[u]; rs[u] = nrs[u]; }
    }
}

typedef float f32x16 __attribute__((ext_vector_type(16)));
typedef unsigned u32x4 __attribute__((ext_vector_type(4)));
typedef unsigned u32x2 __attribute__((ext_vector_type(2)));
__device__ __forceinline__ void p3_attn(Frame& F, const Args& a, unsigned char* ws, int ablk, int nablk) {
    const bf16* Z = (const bf16*)(ws + WS_Z); const bf16* VT = (const bf16*)(ws + WS_VT); bf16* Y = (bf16*)(ws + WS_H);
    const float* sinks = a.in[16]; const float* rel_bias = a.in[17];
    LAS float* tb = (LAS float*)F.lds;
    for (int i = F.tid; i < 16 * 128; i += NTHR) { const int h = i >> 7, d = i & 127;
        int b; if (d < 16) b = d; else { b = 16 + (int)(logf((float)d * (1.f / 16.f)) / logf(8.f) * 16.f); if (b > 31) b = 31; }
        tb[i] = rel_bias[b * 16 + h]; }
    __syncthreads();
    const int lane = F.lane, r = lane & 31, h = lane >> 5;
    for (int item = ablk * NWAVES + F.wave; item < 64 * 16 * 4; item += nablk * NWAVES) {
        const int slab = item & 3, hq = (item >> 2) & 15, nb = item >> 6, hk = hq >> 3;
        const int q0 = nb * 128 + slab * 32;
        bf16x8 qf[4];
#pragma unroll
        for (int s = 0; s < 4; ++s) qf[s] = *(const bf16x8*)(Z + (size_t)(q0 + r) * ZLD + C_Q + hq * 64 + 16 * s + 8 * h);
        f32x16 st[5];
        const LAS float* tbh = tb + hq * 128;
        float mx = sinks[hq];
#pragma unroll
        for (int tt = 0; tt < 5; ++tt) {
            const int jb = q0 - 128 + 32 * tt; int kt = jb + r; if (kt < 0) kt = 0;
            f32x16 acc = (f32x16){0.f,0.f,0.f,0.f,0.f,0.f,0.f,0.f,0.f,0.f,0.f,0.f,0.f,0.f,0.f,0.f};
#pragma unroll
            for (int s = 0; s < 4; ++s) { const bf16x8 kf = *(const bf16x8*)(Z + (size_t)kt * ZLD + C_AK + hk * 64 + 16 * s + 8 * h);
                acc = __builtin_amdgcn_mfma_f32_32x32x16_bf16(kf, qf[s], acc, 0, 0, 0); }
#pragma unroll
            for (int g = 0; g < 16; ++g) { const int jj = 8 * (g >> 2) + 4 * h + (g & 3); const int dist = 128 - 32 * tt + r - jj;
                const bool ok = dist >= 0 && dist < 128 && (jb + jj) >= 0;
                const float v = ok ? acc[g] + tbh[dist & 127] : -INFINITY;
                st[tt][g] = v; mx = fmaxf(mx, v); }
        }
        mx = fmaxf(mx, __shfl_xor(mx, 32));
        float sum = 0.f;
#pragma unroll
        for (int tt = 0; tt < 5; ++tt)
#pragma unroll
            for (int g = 0; g < 16; ++g) { const float e = __expf(st[tt][g] - mx); st[tt][g] = e; sum += e; }
        sum += __shfl_xor(sum, 32);
        sum += __expf(sinks[hq] - mx);
        const float inv = 1.0f / sum;
        f32x16 o0 = (f32x16){0.f,0.f,0.f,0.f,0.f,0.f,0.f,0.f,0.f,0.f,0.f,0.f,0.f,0.f,0.f,0.f}, o1 = o0;
#pragma unroll
        for (int tt = 0; tt < 5; ++tt) {
            const int jb = q0 - 128 + 32 * tt;
#pragma unroll
            for (int s2 = 0; s2 < 2; ++s2) {
                u32x4 pw; pw.x = pk2(st[tt][8 * s2 + 0], st[tt][8 * s2 + 1]); pw.y = pk2(st[tt][8 * s2 + 2], st[tt][8 * s2 + 3]); pw.z = pk2(st[tt][8 * s2 + 4], st[tt][8 * s2 + 5]); pw.w = pk2(st[tt][8 * s2 + 6], st[tt][8 * s2 + 7]);
                const bf16x8 pf = __builtin_bit_cast(bf16x8, pw);
                int k0 = jb + 16 * s2 + 4 * h; int k1 = k0 + 8; if (k0 < 0) k0 = 0; if (k1 < 0) k1 = 0;
#pragma unroll
                for (int dt = 0; dt < 2; ++dt) { const bf16* vrow = VT + (size_t)(hk * 64 + 32 * dt + r) * SEQ;
                    const u32x2 lo = *(const u32x2*)(vrow + k0), hi = *(const u32x2*)(vrow + k1);
                    u32x4 vw; vw.x = lo.x; vw.y = lo.y; vw.z = hi.x; vw.w = hi.y;
                    const bf16x8 vf = __builtin_bit_cast(bf16x8, vw);
                    if (dt == 0) o0 = __builtin_amdgcn_mfma_f32_32x32x16_bf16(vf, pf, o0, 0, 0, 0); else o1 = __builtin_amdgcn_mfma_f32_32x32x16_bf16(vf, pf, o1, 0, 0, 0); }
            }
        }
        const int t = q0 + r;
#pragma unroll
        for (int dt = 0; dt < 2; ++dt)
#pragma unroll
            for (int g4 = 0; g4 < 4; ++g4) { const int d = 32 * dt + 8 * g4 + 4 * h;
                const u32x2 gw = *(const u32x2*)(Z + (size_t)t * ZLD + C_AG + hq * 64 + d);
                const float g0 = bflo(gw.x), g1 = bfhi(gw.x), g2 = bflo(gw.y), g3 = bfhi(gw.y);
                const f32x16& oo = dt == 0 ? o0 : o1;
                const float y0 = oo[4 * g4 + 0] * inv * g0 / (1.f + __expf(-g0)), y1 = oo[4 * g4 + 1] * inv * g1 / (1.f + __expf(-g1));
                const float y2 = oo[4 * g4 + 2] * inv * g2 / (1.f + __expf(-g2)), y3 = oo[4 * g4 + 3] * inv * g3 / (1.f + __expf(-g3));
                u32x2 w; w.x = pk2(y0, y1); w.y = pk2(y2, y3);
                *(u32x2*)(Y + (size_t)t * DM + 1024 + hq * 64 + d) = w; }
    }
}

__device__ __forceinline__ void p4_post(Frame& F, const Args& a, unsigned char* ws) {
    const bf16* RR = (const bf16*)(ws + WS_RR); const bf16* KR = (const bf16*)(ws + WS_KR); const bf16* VV = (const bf16*)(ws + WS_VV); const bf16* AL = (const bf16*)(ws + WS_AL);
    const bf16* Z = (const bf16*)(ws + WS_Z); bf16* Y = (bf16*)(ws + WS_H);
    const float* mu = a.in[4]; const float* k_a = a.in[10]; const float* r_k = a.in[11]; const float* lnx_w = a.in[12]; const float* lnx_b = a.in[13];
    const int gw = blockIdx.x * NWAVES + F.wave, NGW = F.G * NWAVES, lane = F.lane;
    for (int t = gw; t < SEQ; t += NGW) {
        const float* orow = (const float*)(Z + (size_t)t * ZLD);
        for (int hd = 0; hd < NH; ++hd) {
            const int ch = hd * 64 + lane;
            const float o = orow[ch];
            const float mean = wave_sum(o) * (1.f / 64.f); const float d = o - mean;
            const float var = wave_sum(d * d) * (1.f / 64.f);
            const float on = d * (1.0f / sqrtf(var + 64e-5f)) * lnx_w[ch] + lnx_b[ch];
            const size_t b = (size_t)t * DR + ch;
            const float r = bf2f(RR[b]), kr = bf2f(KR[b]), al = bf2f(AL[b]), v = bf2f(VV[b]);
            const float km = kr * (1.f + (al - 1.f) * k_a[ch]);
            const float bs = wave_sum(r * km * r_k[ch]);
            const float val = on + bs * v;
            const float g = zshift(Z, t, C_G + ch, mu[C_G + ch]);
            Y[(size_t)t * DM + ch] = (bf16)f2bf(val * g / (1.f + __expf(-g)));
        }
    }
}

__global__ void __launch_bounds__(NTHR, 2) fwd_kernel(Args args) {
    extern __shared__ __attribute__((aligned(16))) unsigned char lds[];
    Frame F;
    F.lds = (LAS unsigned char*)lds;
    F.MISC = (volatile LAS unsigned*)(F.lds + MISC_OFF);
    F.tid = threadIdx.x; F.lane = F.tid & 63; F.wave = __builtin_amdgcn_readfirstlane(F.tid >> 6);
    F.G = gridDim.x; { const int bx = blockIdx.x; F.vcu = (F.G % 8 == 0) ? (bx % 8) * (F.G / 8) + bx / 8 : bx; }
    unsigned char* ws = args.ws;
    F.ctl = (gu32*)(ws + WS_CTL);
    for (int u = F.tid; u < (LDS_BYTES - LDSCTL_OFF) / 4; u += NTHR) ((LAS unsigned*)(F.lds + LDSCTL_OFF))[u] = 0u;
    __syncthreads();
#if MK_FUSED
    XcdBarrier bar = xcd_barrier_post((unsigned*)(F.ctl + CW_BAR), F.MISC + 8);
#define GRID_BAR() xcd_barrier(bar)
#else
#define GRID_BAR() do {} while (0)
#endif
    const int lo = args.ph_lo, hi = args.ph_hi;
#define IN(k) (lo <= (k) && (k) < hi)
#define BOTH(k) (IN(k) && IN((k) + 1))
    if (IN(0)) { p0_prologue(F, args, ws); if (BOTH(0)) GRID_BAR(); }
    if (IN(1)) {
        pg8::Gemm g{(const pg8::bf16_t*)(ws + WS_H), (const pg8::bf16_t*)(ws + WS_WTIN), SEQ, NPAD, DM}; pg8::StaticOrder S; S.init(SEQ, NPAD, F.G, (int)blockIdx.x);
        pg8::EpiBf16 E{(pg8::bf16_t*)(ws + WS_Z), ZLD};
        pg8::gemm_phase<pg8::EpiBf16, pg8::StaticOrder, true, true>(F.lds, g, S, E);
        if (BOTH(1)) GRID_BAR();
    }
    if (IN(2)) { p2_prep(F, args, ws); if (BOTH(2)) GRID_BAR(); }
    if (IN(3)) {
        if (blockIdx.x < 128) p3_scan(F, args, ws); else p3_attn(F, args, ws, (int)blockIdx.x - 128, F.G - 128);
        if (BOTH(3)) GRID_BAR();
    }
    if (IN(4)) { p4_post(F, args, ws); if (BOTH(4)) GRID_BAR(); }
    if (IN(5)) {
        pg8::Gemm g{(const pg8::bf16_t*)(ws + WS_H), (const pg8::bf16_t*)(ws + WS_WTOUT), SEQ, DM, DM}; pg8::StaticOrder S; S.init(SEQ, DM, F.G, (int)blockIdx.x);
        pg8::EpiResF32 E{args.in[0], args.out, DM};
        pg8::gemm_phase<pg8::EpiResF32, pg8::StaticOrder, true, true>(F.lds, g, S, E);
    }
#undef IN
#undef BOTH
}

extern "C" void kernel_launch(void* const* d_in, const int* in_sizes, int n_in, void* d_out, int out_size, void* d_ws, size_t ws_size, hipStream_t stream) {
    static int grid = 0;
    if (grid == 0) {
        if (n_in != 18 || in_sizes[0] != SEQ * DM || out_size != SEQ * DM || ws_size < WS_END) { fprintf(stderr, "kernel_launch: unexpected shapes (n_in %d, in0 %d, out %d, ws %zu)\n", n_in, n_in > 0 ? in_sizes[0] : -1, out_size, ws_size); grid = -1; return; }
        int dev = 0, cus = 0;
        if (hipGetDevice(&dev) != hipSuccess || hipDeviceGetAttribute(&cus, hipDeviceAttributeMultiprocessorCount, dev) != hipSuccess) { grid = -1; return; }
        if (hipFuncSetAttribute((const void*)fwd_kernel, hipFuncAttributeMaxDynamicSharedMemorySize, LDS_BYTES) != hipSuccess) { fprintf(stderr, "kernel_launch: hipFuncSetAttribute failed\n"); grid = -1; return; }
        (void)hipGetLastError();
        grid = cus;
        if (grid != 256) fprintf(stderr, "kernel_launch: %d CUs (built for 256)\n", grid);
    }
    if (grid < 0) return;
    (void)hipMemsetAsync((char*)d_ws + WS_CTL, 0, CTL_ZERO_BYTES, stream);
    Args a{};
    for (int i = 0; i < 18; ++i) a.in[i] = (const float*)d_in[i];
    a.out = (float*)d_out; a.ws = (unsigned char*)d_ws;
#if MK_FUSED
    a.ph_lo = 0; a.ph_hi = N_PHASES;
    hipLaunchKernelGGL(fwd_kernel, dim3(grid), dim3(NTHR), LDS_BYTES, stream, a);
#else
    for (int p = 0; p < N_PHASES; ++p) { a.ph_lo = p; a.ph_hi = p + 1; hipLaunchKernelGGL(fwd_kernel, dim3(grid), dim3(NTHR), LDS_BYTES, stream, a); }
#endif
}
```

```cpp
#include <hip/hip_runtime.h>
#include <cstdio>
#include <cstdint>
namespace pg8 {
#define PG8_LAS __attribute__((address_space(3)))
typedef unsigned short bf16_t;
typedef short bf16x8 __attribute__((ext_vector_type(8)));
typedef float f32x4 __attribute__((ext_vector_type(4)));
typedef unsigned u32x4 __attribute__((ext_vector_type(4)));
constexpr int BM = 256, BK = 64, HALF = 128, HTB = HALF * BK * 2  , STAGE_BYTES = 8 * HTB, NXCD = 8, WGM = 8;

__host__ __device__ __forceinline__ int lds_byte(int r, int c) { const int st = (r >> 4) * 2 + (c >> 5), rr = r & 15, cc = c & 31, ob = rr * 64 + cc * 2; return st * 1024 + (ob ^ (((ob >> 9) & 1) << 5)); }
__host__ __device__ __forceinline__ void stage_rc(int b, int& R, int& C) { const int st = b / 1024, sb = b % 1024, swz = sb ^ (((sb >> 9) & 1) << 5); R = (st >> 1) * 16 + swz / 64; C = (st & 1) * 32 + (swz % 64) / 2; }
__host__ __device__ __forceinline__ int perm32(int rho) { const int n = rho >> 4, i = rho & 15; return 8 * (i >> 2) + 4 * n + (i & 3); }

struct Unit { int pm, pn; };
struct Gemm { const bf16_t* A; const bf16_t* Bt; int M, N, K; };

struct StaticOrder {
    int nM, nN, nwg, G, c;
    __host__ __device__ void init(int M, int N, int G_, int c_) { nM = M / BM; nN = N / BM; nwg = nM * nN; G = G_; c = c_; }
    __host__ __device__ bool next(int i, Unit& u) const {
        const long L = (long)i * G + c; if (L >= nwg) return false;
        int wgid = (int)L; { const int q = nwg / NXCD, r = nwg % NXCD, xcd = wgid % NXCD, off = wgid / NXCD; wgid = (xcd < r ? xcd * (q + 1) : r * (q + 1) + (xcd - r) * q) + off; }
        const int nig = WGM * nN, gid = wgid / nig, fm = gid * WGM, gsz = (nM - fm) < WGM ? (nM - fm) : WGM;
        u.pm = fm + ((wgid % nig) % gsz); u.pn = (wgid % nig) / gsz; return true;
    }
    __device__ __forceinline__ void a_ready(const Unit&) const {}
    __device__ __forceinline__ void done(const Unit&) const {}
};

__device__ __forceinline__ unsigned cvt_pk_bf16(float lo, float hi) { unsigned r; asm volatile("v_cvt_pk_bf16_f32 %0, %1, %2" : "=v"(r) : "v"(lo), "v"(hi)); return r; }
typedef float f32x2 __attribute__((ext_vector_type(2)));

struct EpiBf16 {
    static constexpr bool PERM = true, AFTER_DRAIN = false;
    bf16_t* O; int ldc;
    __device__ __forceinline__ void operator()(const f32x4 (&acc)[2][2][4][2], const Unit& u, int wr, int wc, int fr, int fq) const {
        const int row0 = u.pm * BM + wr * 64 + fr; const int col0 = u.pn * BM + wc * 32 + 8 * fq;
#pragma unroll
        for (int ai = 0; ai < 2; ++ai)
#pragma unroll
            for (int m = 0; m < 4; ++m) { bf16_t* rowp = O + (size_t)(row0 + ai * HALF + m * 16) * ldc + col0;
#pragma unroll
                for (int bj = 0; bj < 2; ++bj) { const f32x4 v0 = acc[ai][bj][m][0], v1 = acc[ai][bj][m][1];
                    u32x4 w; w.x = cvt_pk_bf16(v0[0], v0[1]); w.y = cvt_pk_bf16(v0[2], v0[3]); w.z = cvt_pk_bf16(v1[0], v1[1]); w.w = cvt_pk_bf16(v1[2], v1[3]);
                    *(u32x4*)(rowp + bj * HALF) = w; } }
    }
};
struct EpiResF32 {
    static constexpr bool PERM = false, AFTER_DRAIN = false;
    const float* base; float* out; int ldc;
    __device__ __forceinline__ void operator()(const f32x4 (&acc)[2][2][4][2], const Unit& u, int wr, int wc, int fr, int fq) const {
        const int row0 = u.pm * BM + wr * 64 + fr; const int col0 = u.pn * BM + wc * 32 + 4 * fq;
#pragma unroll
        for (int ai = 0; ai < 2; ++ai)
#pragma unroll
            for (int m = 0; m < 4; ++m) { const size_t off = (size_t)(row0 + ai * HALF + m * 16) * ldc + col0;
#pragma unroll
                for (int bj = 0; bj < 2; ++bj)
#pragma unroll
                    for (int n = 0; n < 2; ++n) { const f32x4 bs = *(const f32x4*)(base + off + bj * HALF + n * 16); *(f32x4*)(out + off + bj * HALF + n * 16) = bs + acc[ai][bj][m][n]; } }
    }
};
template <class Epi, class Sched, bool ALIGN_EPI = false, bool SP2 = false>
__device__ __forceinline__ void gemm_phase(PG8_LAS unsigned char* lds, const Gemm g, const Sched& S, const Epi& E) {
    const int tid = threadIdx.x, wid = __builtin_amdgcn_readfirstlane(tid >> 6), lane = tid & 63, wr = wid >> 2, wc = wid & 3, fr = lane & 15, fq = lane >> 4;
    const int K = g.K, nt = K / BK;
    unsigned voffA[2], voffB[2];
#pragma unroll
    for (int i = 0; i < 2; ++i) { int R, C; stage_rc(tid * 16 + i * 8192, R, C); const int Rb = Epi::PERM ? ((R & ~31) + perm32(R & 31)) : R;
        voffA[i] = (unsigned)(R * K + C) * 2u; voffB[i] = (unsigned)(Rb * K + C) * 2u; }
    const size_t kstep = (size_t)(BK * 2);
    const size_t hstep = (size_t)HALF * K * 2;
    const size_t tstep = 2 * hstep;
    const unsigned ldsw = (unsigned)wid * 1024u;
    const int aoff = lds_byte(wr * 64 + fr, fq * 8), boff = lds_byte(wc * 32 + fr, fq * 8);
#define PG8_SA(b, h) (((b) * 2 + (h)) * HTB)
#define PG8_SB(b, h) ((4 + (b) * 2 + (h)) * HTB)
#define PG8_STAGE(bufoff, gbase, voff) do { _Pragma("unroll") for (int _i = 0; _i < 2; ++_i) \
        __builtin_amdgcn_global_load_lds((const unsigned*)((const char*)(gbase) + (voff)[_i]), (PG8_LAS unsigned*)(lds + (bufoff) + ldsw + _i * 8192), 16, 0, 0); } while (0)
#define PG8_LDA(dst, b, h) do { _Pragma("unroll") for (int m = 0; m < 4; ++m) _Pragma("unroll") for (int k = 0; k < 2; ++k) dst[m][k] = *(const PG8_LAS bf16x8*)(lds + PG8_SA(b, h) + aoff + m * 2048 + k * 1024); } while (0)
#define PG8_LDB(dst, b, h) do { _Pragma("unroll") for (int n = 0; n < 2; ++n) _Pragma("unroll") for (int k = 0; k < 2; ++k) dst[n][k] = *(const PG8_LAS bf16x8*)(lds + PG8_SB(b, h) + boff + n * 2048 + k * 1024); } while (0)
#define PG8_MMA(ai, bj, At, Bt) do { __builtin_amdgcn_s_setprio(1); _Pragma("unroll") for (int m = 0; m < 4; ++m) _Pragma("unroll") for (int n = 0; n < 2; ++n) _Pragma("unroll") for (int k = 0; k < 2; ++k) \
        acc[ai][bj][m][n] = __builtin_amdgcn_mfma_f32_16x16x32_bf16(Bt[n][k], At[m][k], acc[ai][bj][m][n], 0, 0, 0); __builtin_amdgcn_s_setprio(0); } while (0)
#define PG8_WAIT_V(n) asm volatile("s_waitcnt vmcnt(" #n ")" ::: "memory")
#define PG8_WAIT_L(n) asm volatile("s_waitcnt lgkmcnt(" #n ")" ::: "memory")
#define PG8_BAR __builtin_amdgcn_s_barrier()
#define PG8_SCHED __builtin_amdgcn_sched_barrier(0)
    Unit cur, nxt; int ui = 0;
    if (!S.next(0, cur)) return;
    f32x4 acc[2][2][4][2];
#pragma unroll
    for (int a = 0; a < 2; ++a)
#pragma unroll
        for (int b = 0; b < 2; ++b)
#pragma unroll
            for (int m = 0; m < 4; ++m)
#pragma unroll
                for (int n = 0; n < 2; ++n) acc[a][b][m][n] = (f32x4){0.f, 0.f, 0.f, 0.f};
    bf16x8 At[4][2], B0[2][2], B1[2][2];
    const char* cA = (const char*)g.A + (size_t)cur.pm * tstep; const char* cB = (const char*)g.Bt + (size_t)cur.pn * tstep;
    S.a_ready(cur);
    if constexpr (SP2) {
        PG8_STAGE(PG8_SB(0, 0), cB, voffB); PG8_STAGE(PG8_SB(0, 1), cB + hstep, voffB); PG8_STAGE(PG8_SA(0, 0), cA, voffA); PG8_STAGE(PG8_SA(0, 1), cA + hstep, voffA);
        if (wr == 1) PG8_BAR;
        PG8_WAIT_V(2); PG8_BAR;
        PG8_STAGE(PG8_SB(1, 0), cB + kstep, voffB); PG8_STAGE(PG8_SA(1, 0), cA + kstep, voffA); PG8_STAGE(PG8_SB(1, 1), cB + hstep + kstep, voffB);
        PG8_WAIT_V(6); PG8_BAR;
    } else {
        PG8_STAGE(PG8_SB(0, 0), cB, voffB); PG8_STAGE(PG8_SA(0, 0), cA, voffA); PG8_STAGE(PG8_SB(0, 1), cB + hstep, voffB); PG8_STAGE(PG8_SA(0, 1), cA + hstep, voffA);
        if (wr == 1) PG8_BAR;
        PG8_WAIT_V(4); PG8_BAR;
        PG8_STAGE(PG8_SB(1, 0), cB + kstep, voffB); PG8_STAGE(PG8_SA(1, 0), cA + kstep, voffA); PG8_STAGE(PG8_SB(1, 1), cB + hstep + kstep, voffB);
        PG8_WAIT_V(6); PG8_BAR;
    }
    for (;;) {
        const bool has_next = S.next(ui + 1, nxt);
        const char* nA = has_next ? (const char*)g.A + (size_t)nxt.pm * tstep : cA; const char* nB = has_next ? (const char*)g.Bt + (size_t)nxt.pn * tstep : cB;
        for (int t = 0; t < nt; t += 2) {
            const bool last = (t == nt - 2);
            const char* a1 = cA + (size_t)(t + 1) * kstep;
            const char* a2 = last ? nA : cA + (size_t)(t + 2) * kstep; const char* b2 = last ? nB : cB + (size_t)(t + 2) * kstep;
            const char* a3 = a2 + kstep; const char* b3 = b2 + kstep;
            if (last && has_next) S.a_ready(nxt);
            if constexpr (SP2) {
            PG8_LDB(B0, 0, 0); PG8_LDB(B1, 0, 1); PG8_SCHED; PG8_LDA(At, 0, 0); PG8_STAGE(PG8_SA(1, 1), a1 + hstep, voffA);
            PG8_WAIT_V(8); PG8_WAIT_L(0); PG8_BAR; PG8_MMA(0, 0, At, B0); PG8_MMA(0, 1, At, B1); PG8_BAR; PG8_SCHED;
            PG8_LDA(At, 0, 1); PG8_STAGE(PG8_SB(0, 0), b2, voffB); PG8_STAGE(PG8_SB(0, 1), b2 + hstep, voffB); PG8_STAGE(PG8_SA(0, 0), a2, voffA);
            PG8_WAIT_V(8); PG8_WAIT_L(0); PG8_BAR; PG8_MMA(1, 0, At, B0); PG8_MMA(1, 1, At, B1); PG8_BAR; PG8_SCHED;
            PG8_LDB(B0, 1, 0); PG8_LDB(B1, 1, 1); PG8_SCHED; PG8_LDA(At, 1, 0); PG8_STAGE(PG8_SA(0, 1), a2 + hstep, voffA);
            PG8_WAIT_V(8); PG8_WAIT_L(0); PG8_BAR; PG8_MMA(0, 0, At, B0); PG8_MMA(0, 1, At, B1); PG8_BAR; PG8_SCHED;
            PG8_LDA(At, 1, 1); PG8_STAGE(PG8_SB(1, 0), b3, voffB); PG8_STAGE(PG8_SB(1, 1), b3 + hstep, voffB); PG8_STAGE(PG8_SA(1, 0), a3, voffA);
            PG8_WAIT_V(8); PG8_WAIT_L(0); PG8_BAR; PG8_MMA(1, 0, At, B0); PG8_MMA(1, 1, At, B1); PG8_BAR; PG8_SCHED;
            } else {
            PG8_LDB(B0, 0, 0); PG8_SCHED; PG8_LDA(At, 0, 0); PG8_STAGE(PG8_SA(1, 1), a1 + hstep, voffA);
            PG8_WAIT_L(8); PG8_BAR; PG8_WAIT_L(0); PG8_MMA(0, 0, At, B0); PG8_BAR; PG8_SCHED;
            PG8_LDB(B1, 0, 1); PG8_STAGE(PG8_SB(0, 0), b2, voffB);
            PG8_BAR; PG8_WAIT_L(0); PG8_MMA(0, 1, At, B1); PG8_BAR;
            PG8_LDA(At, 0, 1); PG8_STAGE(PG8_SA(0, 0), a2, voffA);
            PG8_BAR; PG8_WAIT_L(0); PG8_MMA(1, 0, At, B0); PG8_BAR; PG8_SCHED;
            PG8_STAGE(PG8_SB(0, 1), b2 + hstep, voffB);
            PG8_WAIT_V(6); PG8_BAR; PG8_MMA(1, 1, At, B1); PG8_BAR;
            PG8_LDB(B0, 1, 0); PG8_SCHED; PG8_LDA(At, 1, 0); PG8_STAGE(PG8_SA(0, 1), a2 + hstep, voffA);
            PG8_WAIT_L(8); PG8_BAR; PG8_WAIT_L(0); PG8_MMA(0, 0, At, B0); PG8_BAR; PG8_SCHED;
            PG8_LDB(B1, 1, 1); PG8_STAGE(PG8_SB(1, 0), b3, voffB);
            PG8_BAR; PG8_WAIT_L(0); PG8_MMA(0, 1, At, B1); PG8_BAR;
            PG8_LDA(At, 1, 1); PG8_STAGE(PG8_SA(1, 0), a3, voffA);
            PG8_BAR; PG8_WAIT_L(0); PG8_MMA(1, 0, At, B0); PG8_BAR; PG8_SCHED;
            PG8_STAGE(PG8_SB(1, 1), b3 + hstep, voffB);
            PG8_WAIT_V(6); PG8_BAR; PG8_MMA(1, 1, At, B1); PG8_BAR;
            }
        }
        if constexpr (ALIGN_EPI) { if (wr == 0) PG8_BAR; }
        if constexpr (!Epi::AFTER_DRAIN) { E(acc, cur, wr, wc, fr, fq); S.done(cur); }
        if (!has_next) break;
#pragma unroll
        for (int a = 0; a < 2; ++a)
#pragma unroll
            for (int b = 0; b < 2; ++b)
#pragma unroll
                for (int m = 0; m < 4; ++m)
#pragma unroll
                    for (int n = 0; n < 2; ++n) acc[a][b][m][n] = (f32x4){0.f, 0.f, 0.f, 0.f};
        cur = nxt; cA = nA; cB = nB; ++ui;
        if constexpr (ALIGN_EPI) { if (wr == 1) PG8_BAR; }
    }
    PG8_WAIT_V(0);
    if constexpr (!ALIGN_EPI) { if (wr == 0) PG8_BAR; }
    PG8_BAR;
    if constexpr (Epi::AFTER_DRAIN) { E.fused(acc, cur, wr, wc, fr, fq, lds, wid, lane); S.done(cur); }
#undef PG8_SA
#undef PG8_SB
#undef PG8_STAGE
#undef PG8_LDA
#undef PG8_LDB
#undef PG8_MMA
#undef PG8_WAIT_V
#undef PG8_WAIT_L
#undef PG8_BAR
#undef PG8_SCHED
}
}

#define GAS __attribute__((address_space(1)))
#define LAS __attribute__((address_space(3)))
typedef unsigned short bf16;
typedef unsigned v4u __attribute__((ext_vector_type(4)));
typedef float f32x4 __attribute__((ext_vector_type(4)));
typedef short bf16x8 __attribute__((ext_vector_type(8)));
typedef GAS unsigned gu32;
typedef GAS unsigned long long gu64;
#define RLX_AGENT __ATOMIC_RELAXED, __HIP_MEMORY_SCOPE_AGENT
#define LDS_WAIT() asm volatile("s_waitcnt lgkmcnt(0)" ::: "memory")
#define VM_WAIT() asm volatile("s_waitcnt vmcnt(0)" ::: "memory")
__device__ __forceinline__ unsigned long long rt() { return __builtin_amdgcn_s_memrealtime(); }
__device__ __forceinline__ unsigned f2bf(float f) { unsigned u = __builtin_bit_cast(unsigned, f); return (u + 0x7fffu + ((u >> 16) & 1u)) >> 16; }
__device__ __forceinline__ unsigned pk2(float lo, float hi) { return f2bf(lo) | (f2bf(hi) << 16); }


#define XB_TMO      128
#define XB_XCNT(j)  (256  + 64 * (j))
#define XB_XSUB(j)  (1280 + 64 * (j))
#define XB_XGEN(j)  (2304 + 64 * (j))
#define XB_TOP      3328
#define XB_TOPGEN   3392
#define XCD_BAR_WORDS 3456
#define XB_SPIN_CAP (1u << 18)

__device__ __forceinline__ unsigned xb_ld(unsigned* p)              { return __hip_atomic_load(p, __ATOMIC_RELAXED, __HIP_MEMORY_SCOPE_AGENT); }
__device__ __forceinline__ unsigned xb_add(unsigned* p, unsigned v) { return __hip_atomic_fetch_add(p, v, __ATOMIC_RELAXED, __HIP_MEMORY_SCOPE_AGENT); }
__device__ __forceinline__ unsigned xb_xcc_id() { return (unsigned)__builtin_amdgcn_s_getreg((3 << 11) | 20) & 0xFu; }
#define XB_SPIN(cond, bar) do { unsigned _sp = 0; while (cond) { __builtin_amdgcn_s_sleep(1); \
    if ((++_sp & 255u) == 0u) { if (xb_ld(&(bar)[XB_TMO])) break; if (_sp > XB_SPIN_CAP) { atomicAdd(&(bar)[XB_TMO], 1u); break; } } } } while (0)

struct XcdBarrier {
    unsigned* bar; unsigned x;
    volatile LAS unsigned* st;
};

__device__ __forceinline__ XcdBarrier xcd_barrier_post(unsigned* bar, volatile LAS unsigned* st) {
    XcdBarrier b; b.bar = bar; b.x = xb_xcc_id(); b.st = st;
    if (threadIdx.x == 0) (void)xb_add(&bar[XB_XCNT(b.x)], 1u);
    return b;
}
__device__ __forceinline__ void xcd_barrier_complete(unsigned* bar, unsigned x, unsigned& nloc, unsigned& nx) {
    const unsigned G = gridDim.x * gridDim.y * gridDim.z;
    unsigned sum, cnt, mine, sp = 0u;
    for (;;) {
        sum = 0u; cnt = 0u; mine = 0u;
#pragma unroll
        for (unsigned j = 0; j < 16; ++j) { const unsigned c = xb_ld(&bar[XB_XCNT(j)]); sum += c; cnt += (c > 0u) ? 1u : 0u; mine = (j == x) ? c : mine; }
        if (sum == G) break;
        __builtin_amdgcn_s_sleep(1);
        if ((++sp & 255u) == 0u) { if (xb_ld(&bar[XB_TMO])) break; if (sp > XB_SPIN_CAP) { atomicAdd(&bar[XB_TMO], 1u); break; } }
    }
    nloc = mine > 0u ? mine : 1u; nx = cnt > 0u ? cnt : 1u;
}

__device__ __forceinline__ void xcd_barrier(const XcdBarrier& b) {
    asm volatile("s_waitcnt vmcnt(0)" ::: "memory");
    __syncthreads();
    if (threadIdx.x == 0) {
        unsigned* bar = b.bar;
        __builtin_amdgcn_s_waitcnt(0);
        unsigned nloc = b.st[0], nx = b.st[1];
        if (nloc == 0u) { xcd_barrier_complete(bar, b.x, nloc, nx); b.st[0] = nloc; b.st[1] = nx; }
        const unsigned old = xb_add(&bar[XB_XSUB(b.x)], 1u);
        const unsigned gen = old / nloc;
        if (old + 1u == (gen + 1u) * nloc) {
            __builtin_amdgcn_fence(__ATOMIC_RELEASE, "agent");
            asm volatile("s_waitcnt vmcnt(0)" ::: "memory");
            const unsigned og = xb_add(&bar[XB_TOP], 1u);
            const unsigned tg = og / nx;
            if (og + 1u == (tg + 1u) * nx) xb_add(&bar[XB_TOPGEN], 1u);
            else XB_SPIN(xb_ld(&bar[XB_TOPGEN]) == tg, bar);
            __builtin_amdgcn_fence(__ATOMIC_ACQUIRE, "agent");
            xb_add(&bar[XB_XGEN(b.x)], 1u);
            asm volatile("s_waitcnt vmcnt(0)" ::: "memory");
        } else {
            XB_SPIN(xb_ld(&bar[XB_XGEN(b.x)]) == gen, bar);
            __builtin_amdgcn_fence(__ATOMIC_ACQUIRE, "agent");
            asm volatile("s_waitcnt vmcnt(0)" ::: "memory");
        }
    }
    __syncthreads();
}

constexpr int NWAVES = 8, NTHR = 512;
constexpr int SEQ = 8192, DM = 2048, DIN = 6528, NPAD = 6656, ZLD = 6656;
constexpr int C_R = 0, C_K = 1024, C_V = 2048, C_G = 3072, C_WL = 4096, C_AL = 4160, C_Q = 4224, C_AK = 5248, C_AV = 5376, C_AG = 5504;
constexpr int NH = 16, HD = 64, DR = 1024;
#ifndef MK_FUSED
#define MK_FUSED 1
#endif
constexpr int N_PHASES = 6;
constexpr size_t MiB = 1u << 20;
constexpr size_t WS_CTL = 0, CTL_ZERO_BYTES = 1 * MiB;
constexpr size_t WS_WTOUT = 1 * MiB;
constexpr size_t WS_Z = 9 * MiB;
constexpr size_t WS_H = 113 * MiB;
constexpr size_t WS_WTIN = 145 * MiB;
constexpr size_t WS_RR = 145 * MiB, WS_KR = 161 * MiB, WS_VV = 177 * MiB, WS_AL = 193 * MiB;
constexpr size_t WS_LOGD = 209 * MiB;
constexpr size_t WS_VT = 241 * MiB;
constexpr size_t WS_RS = 243 * MiB;
constexpr size_t WS_END = 256 * MiB;
constexpr int CW_BAR = 4096;
constexpr int RING_BYTES = 131072, LDSCTL_OFF = RING_BYTES, MISC_OFF = LDSCTL_OFF + 320, LDS_BYTES = 147456;

struct Frame {
    LAS unsigned char* lds;
    volatile LAS unsigned* MISC;
    gu32* ctl;
    int tid, lane, wave, vcu, G;
};
struct Args { const float* in[18]; float* out; unsigned char* ws; int ph_lo, ph_hi; };

__device__ __forceinline__ float wave_sum(float v) {
#pragma unroll
    for (int o = 1; o < 64; o <<= 1) v += __shfl_xor(v, o);
    return v;
}
__device__ __forceinline__ float bf2f(bf16 b) { return __builtin_bit_cast(float, (unsigned)b << 16); }
__device__ __forceinline__ float bflo(unsigned w) { return __builtin_bit_cast(float, w << 16); }
__device__ __forceinline__ float bfhi(unsigned w) { return __builtin_bit_cast(float, w & 0xffff0000u); }

__device__ __forceinline__ void p0_transpose_item(const float* W, int K, int N, bf16* WT, LAS float* scr, int item, int lane) {
    const int nblk = N / 32, kb = item / nblk, nb = item % nblk, k0 = 64 * kb, n0 = 32 * nb;
#pragma unroll 8
    for (int i = 0; i < 32; ++i) { const int kk = 2 * i + (lane >> 5); scr[kk * 33 + (lane & 31)] = W[(size_t)(k0 + kk) * N + n0 + (lane & 31)]; }
    LDS_WAIT(); asm volatile("" ::: "memory");
    const int c = lane & 7;
#pragma unroll
    for (int j = 0; j < 4; ++j) { const int n = (lane >> 3) + 8 * j; const LAS float* s = scr + (8 * c) * 33 + n;
        v4u o; o.x = pk2(s[0 * 33], s[1 * 33]); o.y = pk2(s[2 * 33], s[3 * 33]); o.z = pk2(s[4 * 33], s[5 * 33]); o.w = pk2(s[6 * 33], s[7 * 33]);
        *(GAS v4u*)(WT + (size_t)(n0 + n) * K + k0 + 8 * c) = o; }
    LDS_WAIT(); asm volatile("" ::: "memory");
}

__device__ __forceinline__ void p0_prologue(Frame& F, const Args& a, unsigned char* ws) {
    const float* x = a.in[0]; const float* norm_w = a.in[1]; const float* w_in = a.in[2]; const float* w_out = a.in[3];
    bf16* WTIN = (bf16*)(ws + WS_WTIN); bf16* WTOUT = (bf16*)(ws + WS_WTOUT); bf16* H = (bf16*)(ws + WS_H);
    LAS float* scr = (LAS float*)(F.lds + F.wave * 16384);
    const int gw = F.vcu * NWAVES + F.wave, NGW = F.G * NWAVES;
    constexpr int I_IN = (DM / 64) * (DIN / 32), I_OUT = (DM / 64) * (DM / 32);
    for (int it = gw; it < I_IN + I_OUT; it += NGW) {
        if (it < I_IN) p0_transpose_item(w_in, DM, DIN, WTIN, scr, it, F.lane);
        else p0_transpose_item(w_out, DM, DM, WTOUT, scr, it - I_IN, F.lane);
    }
    { GAS v4u* p = (GAS v4u*)(WTIN + (size_t)DIN * DM); const int n16 = (NPAD - DIN) * DM * 2 / 16;
      for (int i = blockIdx.x * NTHR + F.tid; i < n16; i += F.G * NTHR) p[i] = (v4u){0u, 0u, 0u, 0u}; }
    for (int m = gw; m < SEQ; m += NGW) {
        const GAS f32x4* xr = (const GAS f32x4*)(x + (size_t)m * DM) + F.lane;
        f32x4 v[8]; float s = 0.f;
#pragma unroll
        for (int j = 0; j < 8; ++j) { v[j] = xr[64 * j]; s += (v[j].x * v[j].x + v[j].y * v[j].y) + (v[j].z * v[j].z + v[j].w * v[j].w); }
        const float rstd = 1.0f / sqrtf(wave_sum(s) * (1.f / DM) + 1e-6f);
        GAS unsigned long long* o8 = (GAS unsigned long long*)(H + (size_t)m * DM) + F.lane;
        const GAS f32x4* nw = (const GAS f32x4*)norm_w + F.lane;
#pragma unroll
        for (int j = 0; j < 8; ++j) { const f32x4 g = nw[64 * j];
            o8[64 * j] = (unsigned long long)pk2(v[j].x * rstd * g.x, v[j].y * rstd * g.y) | ((unsigned long long)pk2(v[j].z * rstd * g.z, v[j].w * rstd * g.w) << 32); }
    }
}

__device__ __forceinline__ float zshift(const bf16* Z, int t, int col, float mu) {
    const float zc = bf2f(Z[(size_t)t * ZLD + col]); const float zp = t > 0 ? bf2f(Z[(size_t)(t - 1) * ZLD + col]) : 0.f;
    return zc + (zp - zc) * mu;
}
__device__ __forceinline__ void p2_prep(Frame& F, const Args& a, unsigned char* ws) {
    bf16* Z = (bf16*)(ws + WS_Z);
    bf16* RR = (bf16*)(ws + WS_RR); bf16* KR = (bf16*)(ws + WS_KR); bf16* VV = (bf16*)(ws + WS_VV); bf16* AL = (bf16*)(ws + WS_AL);
    float* LOGD = (float*)(ws + WS_LOGD); bf16* VT = (bf16*)(ws + WS_VT); float* RS = (float*)(ws + WS_RS);
    const float* mu = a.in[4]; const float* w0 = a.in[5]; const float* w2 = a.in[6]; const float* a0 = a.in[7]; const float* a2 = a.in[8];
    const float* k_k = a.in[9]; const float* qnw = a.in[14]; const float* knw = a.in[15];
    LAS float* th = (LAS float*)F.lds;
    LAS float* alv = th + 512;
    const int tid = F.tid, lane = F.lane, wave = F.wave;
    for (int it = blockIdx.x; it < SEQ / 8; it += F.G) {
        const int t0 = it * 8;
        __syncthreads();
        { const int tok = tid >> 6, j = tid & 63, t = t0 + tok;
          th[tok * 64 + j] = tanhf(zshift(Z, t, C_WL + j, mu[C_WL + j]));
          alv[tok * 64 + j] = zshift(Z, t, C_AL + j, mu[C_AL + j]); }
        __syncthreads();
        { float accw[2][8], acca[2][8];
#pragma unroll
          for (int c = 0; c < 2; ++c)
#pragma unroll
              for (int k = 0; k < 8; ++k) { accw[c][k] = 0.f; acca[c][k] = 0.f; }
          for (int j = 0; j < 64; ++j) {
              const float w2a = w2[j * DR + tid], w2b = w2[j * DR + tid + 512], a2a = a2[j * DR + tid], a2b = a2[j * DR + tid + 512];
#pragma unroll
              for (int k = 0; k < 8; ++k) { const float tv = th[k * 64 + j], av = alv[k * 64 + j];
                  accw[0][k] += tv * w2a; accw[1][k] += tv * w2b; acca[0][k] += av * a2a; acca[1][k] += av * a2b; }
          }
#pragma unroll
          for (int c = 0; c < 2; ++c) { const int ch = tid + 512 * c; const float w0c = w0[ch], a0c = a0[ch];
#pragma unroll
              for (int k = 0; k < 8; ++k) {
                  const float nx = -(w0c + accw[c][k]);
                  const float sp = nx > 20.f ? nx : log1pf(expf(nx));
                  const float wv = -sp - 0.5f;
                  LOGD[(size_t)(t0 + k) * DR + ch] = -expf(wv);
                  const float alr = 1.f / (1.f + expf(-(a0c + acca[c][k])));
                  AL[(size_t)(t0 + k) * DR + ch] = (bf16)f2bf(alr);
              } }
        }
        for (int item = tid; item < 8 * 384; item += NTHR) {
            const int tok = item / 384, cv = item % 384, col = cv * 8, t = t0 + tok;
            const v4u zc = *(const v4u*)(Z + (size_t)t * ZLD + col);
            v4u zp = (v4u){0u, 0u, 0u, 0u}; if (t > 0) zp = *(const v4u*)(Z + (size_t)(t - 1) * ZLD + col);
            const f32x4 m0 = *(const f32x4*)(mu + col), m1 = *(const f32x4*)(mu + col + 4);
            float o[8];
            { float c_, p_;
              c_ = bflo(zc.x); p_ = bflo(zp.x); o[0] = c_ + (p_ - c_) * m0.x;  c_ = bfhi(zc.x); p_ = bfhi(zp.x); o[1] = c_ + (p_ - c_) * m0.y;
              c_ = bflo(zc.y); p_ = bflo(zp.y); o[2] = c_ + (p_ - c_) * m0.z;  c_ = bfhi(zc.y); p_ = bfhi(zp.y); o[3] = c_ + (p_ - c_) * m0.w;
              c_ = bflo(zc.z); p_ = bflo(zp.z); o[4] = c_ + (p_ - c_) * m1.x;  c_ = bfhi(zc.z); p_ = bfhi(zp.z); o[5] = c_ + (p_ - c_) * m1.y;
              c_ = bflo(zc.w); p_ = bflo(zp.w); o[6] = c_ + (p_ - c_) * m1.z;  c_ = bfhi(zc.w); p_ = bfhi(zp.w); o[7] = c_ + (p_ - c_) * m1.w; }
            v4u w; w.x = pk2(o[0], o[1]); w.y = pk2(o[2], o[3]); w.z = pk2(o[4], o[5]); w.w = pk2(o[6], o[7]);
            bf16* dst = (col < 1024) ? RR : (col < 2048 ? KR : VV);
            *(v4u*)(dst + (size_t)t * DR + (col & 1023)) = w;
        }
        for (int hv = wave; hv < 8 * 16; hv += NWAVES) {
            const int tok = hv >> 4, h = hv & 15, t = t0 + tok, ch = h * 64 + lane;
            const float kr = bf2f((bf16)f2bf(zshift(Z, t, C_K + ch, mu[C_K + ch])));
            const float kp = kr * k_k[ch];
            const float n2 = wave_sum(kp * kp);
            if (lane == 0) RS[(size_t)t * 16 + h] = 1.0f / sqrtf(fmaxf(n2, 1e-24f));
        }
        for (int hv = wave; hv < 8 * 18; hv += NWAVES) {
            const int tok = hv / 18, hh = hv % 18, t = t0 + tok;
            const int col = hh < 16 ? C_Q + hh * 64 : C_AK + (hh - 16) * 64;
            bf16* p = Z + (size_t)t * ZLD + col + lane;
            const float v = bf2f(*p);
            const float ss = wave_sum(v * v);
            const float rstd = 1.0f / sqrtf(ss * (1.f / 64.f) + 1e-6f);
            const float g = hh < 16 ? qnw[lane] * 0.125f : knw[lane];
            *p = (bf16)f2bf(v * rstd * g);
        }
        { const int dcol = tid & 127, tp = tid >> 7, t = t0 + 2 * tp;
          const unsigned lo = Z[(size_t)t * ZLD + C_AV + dcol], hi = Z[(size_t)(t + 1) * ZLD + C_AV + dcol];
          *(unsigned*)(VT + (size_t)dcol * SEQ + t) = lo | (hi << 16); }
    }
}

__device__ __forceinline__ void p3_scan(Frame& F, const Args& a, unsigned char* ws) {
    const bf16* RR = (const bf16*)(ws + WS_RR); const bf16* KR = (const bf16*)(ws + WS_KR); const bf16* VV = (const bf16*)(ws + WS_VV); const bf16* AL = (const bf16*)(ws + WS_AL);
    const float* LOGD = (const float*)(ws + WS_LOGD); const float* RS = (const float*)(ws + WS_RS);
    bf16* Z = (bf16*)(ws + WS_Z);
    const float* k_k = a.in[9]; const float* k_a = a.in[10];
    const int head = blockIdx.x >> 3, row = (blockIdx.x & 7) * 8 + F.wave, lane = F.lane;
    const int ch = head * 64 + lane;
    const float kkc = k_k[ch], kac = k_a[ch];
    float s = 0.f;
    constexpr int U = 4;
    float kr[U], al[U], rr[U], vr[U], ld[U], rs[U];
#pragma unroll
    for (int u = 0; u < U; ++u) { const size_t b = (size_t)u * DR; kr[u] = bf2f(KR[b + ch]); al[u] = bf2f(AL[b + ch]); rr[u] = bf2f(RR[b + ch]); vr[u] = bf2f(VV[b + head * 64 + row]); ld[u] = LOGD[b + ch]; rs[u] = RS[u * 16 + head]; }
    for (int t = 0; t < SEQ; t += U) {
        float nkr[U], nal[U], nrr[U], nvr[U], nld[U], nrs[U];
        const int tn = (t + U < SEQ) ? t + U : t;
#pragma unroll
        for (int u = 0; u < U; ++u) { const size_t b = (size_t)(tn + u) * DR; nkr[u] = bf2f(KR[b + ch]); nal[u] = bf2f(AL[b + ch]); nrr[u] = bf2f(RR[b + ch]); nvr[u] = bf2f(VV[b + head * 64 + row]); nld[u] = LOGD[b + ch]; nrs[u] = RS[(size_t)(tn + u) * 16 + head]; }
#pragma unroll
        for (int u = 0; u < U; ++u) {
            const float kk = kr[u] * kkc * rs[u];
            const float bb = kk * al[u];
            const float km = kr[u] * (1.f + (al[u] - 1.f) * kac);
            const float w = expf(ld[u]);
            const float sa = -wave_sum(s * kk);
            s = s * w + sa * bb + vr[u] * km;
            const float o = wave_sum(s * rr[u]);
            if (lane == 0) ((float*)(Z + (size_t)(t + u) * ZLD))[head * 64 + row] = o;
        }
#pragma unroll
        for (int u = 0; u < U; ++u) { kr[u] = nkr[u]; al[u] = nal[u]; rr[u] = nrr[u]; vr[u] = nvr[u]; ld[u] = nld[u]; rs[u] = nrs[u]; }
    }
}

typedef float f32x16 __attribute__((ext_vector_type(16)));
typedef unsigned u32x4 __attribute__((ext_vector_type(4)));
typedef unsigned u32x2 __attribute__((ext_vector_type(2)));
__device__ __forceinline__ void p3_attn(Frame& F, const Args& a, unsigned char* ws, int ablk, int nablk) {
    const bf16* Z = (const bf16*)(ws + WS_Z); const bf16* VT = (const bf16*)(ws + WS_VT); bf16* Y = (bf16*)(ws + WS_H);
    const float* sinks = a.in[16]; const float* rel_bias = a.in[17];
    LAS float* tb = (LAS float*)F.lds;
    for (int i = F.tid; i < 16 * 128; i += NTHR) { const int h = i >> 7, d = i & 127;
        int b; if (d < 16) b = d; else { b = 16 + (int)(logf((float)d * (1.f / 16.f)) / logf(8.f) * 16.f); if (b > 31) b = 31; }
        tb[i] = rel_bias[b * 16 + h]; }
    __syncthreads();
    const int lane = F.lane, r = lane & 31, h = lane >> 5;
    for (int item = ablk * NWAVES + F.wave; item < 64 * 16 * 4; item += nablk * NWAVES) {
        const int slab = item & 3, hq = (item >> 2) & 15, nb = item >> 6, hk = hq >> 3;
        const int q0 = nb * 128 + slab * 32;
        bf16x8 qf[4];
#pragma unroll
        for (int s = 0; s < 4; ++s) qf[s] = *(const bf16x8*)(Z + (size_t)(q0 + r) * ZLD + C_Q + hq * 64 + 16 * s + 8 * h);
        f32x16 st[5];
        const LAS float* tbh = tb + hq * 128;
        float mx = sinks[hq];
#pragma unroll
        for (int tt = 0; tt < 5; ++tt) {
            const int jb = q0 - 128 + 32 * tt; int kt = jb + r; if (kt < 0) kt = 0;
            f32x16 acc = (f32x16){0.f,0.f,0.f,0.f,0.f,0.f,0.f,0.f,0.f,0.f,0.f,0.f,0.f,0.f,0.f,0.f};
#pragma unroll
            for (int s = 0; s < 4; ++s) { const bf16x8 kf = *(const bf16x8*)(Z + (size_t)kt * ZLD + C_AK + hk * 64 + 16 * s + 8 * h);
                acc = __builtin_amdgcn_mfma_f32_32x32x16_bf16(kf, qf[s], acc, 0, 0, 0); }
#pragma unroll
            for (int g = 0; g < 16; ++g) { const int jj = 8 * (g >> 2) + 4 * h + (g & 3); const int dist = 128 - 32 * tt + r - jj;
                const bool ok = dist >= 0 && dist < 128 && (jb + jj) >= 0;
                const float v = ok ? acc[g] + tbh[dist & 127] : -INFINITY;
                st[tt][g] = v; mx = fmaxf(mx, v); }
        }
        mx = fmaxf(mx, __shfl_xor(mx, 32));
        float sum = 0.f;
#pragma unroll
        for (int tt = 0; tt < 5; ++tt)
#pragma unroll
            for (int g = 0; g < 16; ++g) { const float e = __expf(st[tt][g] - mx); st[tt][g] = e; sum += e; }
        sum += __shfl_xor(sum, 32);
        sum += __expf(sinks[hq] - mx);
        const float inv = 1.0f / sum;
        f32x16 o0 = (f32x16){0.f,0.f,0.f,0.f,0.f,0.f,0.f,0.f,0.f,0.f,0.f,0.f,0.f,0.f,0.f,0.f}, o1 = o0;
#pragma unroll
        for (int tt = 0; tt < 5; ++tt) {
            const int jb = q0 - 128 + 32 * tt;
#pragma unroll
            for (int s2 = 0; s2 < 2; ++s2) {
                u32x4 pw; pw.x = pk2(st[tt][8 * s2 + 0], st[tt][8 * s2 + 1]); pw.y = pk2(st[tt][8 * s2 + 2], st[tt][8 * s2 + 3]); pw.z = pk2(st[tt][8 * s2 + 4], st[tt][8 * s2 + 5]); pw.w = pk2(st[tt][8 * s2 + 6], st[tt][8 * s2 + 7]);
                const bf16x8 pf = __builtin_bit_cast(bf16x8, pw);
                int k0 = jb + 16 * s2 + 4 * h; int k1 = k0 + 8; if (k0 < 0) k0 = 0; if (k1 < 0) k1 = 0;
#pragma unroll
                for (int dt = 0; dt < 2; ++dt) { const bf16* vrow = VT + (size_t)(hk * 64 + 32 * dt + r) * SEQ;
                    const u32x2 lo = *(const u32x2*)(vrow + k0), hi = *(const u32x2*)(vrow + k1);
                    u32x4 vw; vw.x = lo.x; vw.y = lo.y; vw.z = hi.x; vw.w = hi.y;
                    const bf16x8 vf = __builtin_bit_cast(bf16x8, vw);
                    if (dt == 0) o0 = __builtin_amdgcn_mfma_f32_32x32x16_bf16(vf, pf, o0, 0, 0, 0); else o1 = __builtin_amdgcn_mfma_f32_32x32x16_bf16(vf, pf, o1, 0, 0, 0); }
            }
        }
        const int t = q0 + r;
#pragma unroll
        for (int dt = 0; dt < 2; ++dt)
#pragma unroll
            for (int g4 = 0; g4 < 4; ++g4) { const int d = 32 * dt + 8 * g4 + 4 * h;
                const u32x2 gw = *(const u32x2*)(Z + (size_t)t * ZLD + C_AG + hq * 64 + d);
                const float g0 = bflo(gw.x), g1 = bfhi(gw.x), g2 = bflo(gw.y), g3 = bfhi(gw.y);
                const f32x16& oo = dt == 0 ? o0 : o1;
                const float y0 = oo[4 * g4 + 0] * inv * g0 / (1.f + __expf(-g0)), y1 = oo[4 * g4 + 1] * inv * g1 / (1.f + __expf(-g1));
                const float y2 = oo[4 * g4 + 2] * inv * g2 / (1.f + __expf(-g2)), y3 = oo[4 * g4 + 3] * inv * g3 / (1.f + __expf(-g3));
                u32x2 w; w.x = pk2(y0, y1); w.y = pk2(y2, y3);
                *(u32x2*)(Y + (size_t)t * DM + 1024 + hq * 64 + d) = w; }
    }
}

__device__ __forceinline__ void p4_post(Frame& F, const Args& a, unsigned char* ws) {
    const bf16* RR = (const bf16*)(ws + WS_RR); const bf16* KR = (const bf16*)(ws + WS_KR); const bf16* VV = (const bf16*)(ws + WS_VV); const bf16* AL = (const bf16*)(ws + WS_AL);
    const bf16* Z = (const bf16*)(ws + WS_Z); bf16* Y = (bf16*)(ws + WS_H);
    const float* mu = a.in[4]; const float* k_a = a.in[10]; const float* r_k = a.in[11]; const float* lnx_w = a.in[12]; const float* lnx_b = a.in[13];
    const int gw = blockIdx.x * NWAVES + F.wave, NGW = F.G * NWAVES, lane = F.lane;
    for (int t = gw; t < SEQ; t += NGW) {
        const float* orow = (const float*)(Z + (size_t)t * ZLD);
        for (int hd = 0; hd < NH; ++hd) {
            const int ch = hd * 64 + lane;
            const float o = orow[ch];
            const float mean = wave_sum(o) * (1.f / 64.f); const float d = o - mean;
            const float var = wave_sum(d * d) * (1.f / 64.f);
            const float on = d * (1.0f / sqrtf(var + 64e-5f)) * lnx_w[ch] + lnx_b[ch];
            const size_t b = (size_t)t * DR + ch;
            const float r = bf2f(RR[b]), kr = bf2f(KR[b]), al = bf2f(AL[b]), v = bf2f(VV[b]);
            const float km = kr * (1.f + (al - 1.f) * k_a[ch]);
            const float bs = wave_sum(r * km * r_k[ch]);
            const float val = on + bs * v;
            const float g = zshift(Z, t, C_G + ch, mu[C_G + ch]);
            Y[(size_t)t * DM + ch] = (bf16)f2bf(val * g / (1.f + __expf(-g)));
        }
    }
}

__global__ void __launch_bounds__(NTHR, 2) fwd_kernel(Args args) {
    extern __shared__ __attribute__((aligned(16))) unsigned char lds[];
    Frame F;
    F.lds = (LAS unsigned char*)lds;
    F.MISC = (volatile LAS unsigned*)(F.lds + MISC_OFF);
    F.tid = threadIdx.x; F.lane = F.tid & 63; F.wave = __builtin_amdgcn_readfirstlane(F.tid >> 6);
    F.G = gridDim.x; { const int bx = blockIdx.x; F.vcu = (F.G % 8 == 0) ? (bx % 8) * (F.G / 8) + bx / 8 : bx; }
    unsigned char* ws = args.ws;
    F.ctl = (gu32*)(ws + WS_CTL);
    for (int u = F.tid; u < (LDS_BYTES - LDSCTL_OFF) / 4; u += NTHR) ((LAS unsigned*)(F.lds + LDSCTL_OFF))[u] = 0u;
    __syncthreads();
#if MK_FUSED
    XcdBarrier bar = xcd_barrier_post((unsigned*)(F.ctl + CW_BAR), F.MISC + 8);
#define GRID_BAR() xcd_barrier(bar)
#else
#define GRID_BAR() do {} while (0)
#endif
    const int lo = args.ph_lo, hi = args.ph_hi;
#define IN(k) (lo <= (k) && (k) < hi)
#define BOTH(k) (IN(k) && IN((k) + 1))
    if (IN(0)) { p0_prologue(F, args, ws); if (BOTH(0)) GRID_BAR(); }
    if (IN(1)) {
        pg8::Gemm g{(const pg8::bf16_t*)(ws + WS_H), (const pg8::bf16_t*)(ws + WS_WTIN), SEQ, NPAD, DM}; pg8::StaticOrder S; S.init(SEQ, NPAD, F.G, (int)blockIdx.x);
        pg8::EpiBf16 E{(pg8::bf16_t*)(ws + WS_Z), ZLD};
        pg8::gemm_phase<pg8::EpiBf16, pg8::StaticOrder, true, true>(F.lds, g, S, E);
        if (BOTH(1)) GRID_BAR();
    }
    if (IN(2)) { p2_prep(F, args, ws); if (BOTH(2)) GRID_BAR(); }
    if (IN(3)) {
        if (blockIdx.x < 128) p3_scan(F, args, ws); else p3_attn(F, args, ws, (int)blockIdx.x - 128, F.G - 128);
        if (BOTH(3)) GRID_BAR();
    }
    if (IN(4)) { p4_post(F, args, ws); if (BOTH(4)) GRID_BAR(); }
    if (IN(5)) {
        pg8::Gemm g{(const pg8::bf16_t*)(ws + WS_H), (const pg8::bf16_t*)(ws + WS_WTOUT), SEQ, DM, DM}; pg8::StaticOrder S; S.init(SEQ, DM, F.G, (int)blockIdx.x);
        pg8::EpiResF32 E{args.in[0], args.out, DM};
        pg8::gemm_phase<pg8::EpiResF32, pg8::StaticOrder, true, true>(F.lds, g, S, E);
    }
#undef IN
#undef BOTH
}

extern "C" void kernel_launch(void* const* d_in, const int* in_sizes, int n_in, void* d_out, int out_size, void* d_ws, size_t ws_size, hipStream_t stream) {
    static int grid = 0;
    if (grid == 0) {
        if (n_in != 18 || in_sizes[0] != SEQ * DM || out_size != SEQ * DM || ws_size < WS_END) { fprintf(stderr, "kernel_launch: unexpected shapes (n_in %d, in0 %d, out %d, ws %zu)\n", n_in, n_in > 0 ? in_sizes[0] : -1, out_size, ws_size); grid = -1; return; }
        int dev = 0, cus = 0;
        if (hipGetDevice(&dev) != hipSuccess || hipDeviceGetAttribute(&cus, hipDeviceAttributeMultiprocessorCount, dev) != hipSuccess) { grid = -1; return; }
        if (hipFuncSetAttribute((const void*)fwd_kernel, hipFuncAttributeMaxDynamicSharedMemorySize, LDS_BYTES) != hipSuccess) { fprintf(stderr, "kernel_launch: hipFuncSetAttribute failed\n"); grid = -1; return; }
        (void)hipGetLastError();
        grid = cus;
        if (grid != 256) fprintf(stderr, "kernel_launch: %d CUs (built for 256)\n", grid);
    }
    if (grid < 0) return;
    (void)hipMemsetAsync((char*)d_ws + WS_CTL, 0, CTL_ZERO_BYTES, stream);
    Args a{};
    for (int i = 0; i < 18; ++i) a.in[i] = (const float*)d_in[i];
    a.out = (float*)d_out; a.ws = (unsigned char*)d_ws;
#if MK_FUSED
    a.ph_lo = 0; a.ph_hi = N_PHASES;
    hipLaunchKernelGGL(fwd_kernel, dim3(grid), dim3(NTHR), LDS_BYTES, stream, a);
#else
    for (int p = 0; p < N_PHASES; ++p) { a.ph_lo = p; a.ph_hi = p + 1; hipLaunchKernelGGL(fwd_kernel, dim3(grid), dim3(NTHR), LDS_BYTES, stream, a); }
#endif
}
```

```cpp
#include <hip/hip_runtime.h>
#include <cstdio>
#include <cstdint>
namespace pg8 {
#define PG8_LAS __attribute__((address_space(3)))
typedef unsigned short bf16_t;
typedef short bf16x8 __attribute__((ext_vector_type(8)));
typedef float f32x4 __attribute__((ext_vector_type(4)));
typedef unsigned u32x4 __attribute__((ext_vector_type(4)));
constexpr int BM = 256, BK = 64, HALF = 128, HTB = HALF * BK * 2  , STAGE_BYTES = 8 * HTB, NXCD = 8, WGM = 8;

__host__ __device__ __forceinline__ int lds_byte(int r, int c) { const int st = (r >> 4) * 2 + (c >> 5), rr = r & 15, cc = c & 31, ob = rr * 64 + cc * 2; return st * 1024 + (ob ^ (((ob >> 9) & 1) << 5)); }
__host__ __device__ __forceinline__ void stage_rc(int b, int& R, int& C) { const int st = b / 1024, sb = b % 1024, swz = sb ^ (((sb >> 9) & 1) << 5); R = (st >> 1) * 16 + swz / 64; C = (st & 1) * 32 + (swz % 64) / 2; }
__host__ __device__ __forceinline__ int perm32(int rho) { const int n = rho >> 4, i = rho & 15; return 8 * (i >> 2) + 4 * n + (i & 3); }

struct Unit { int pm, pn; };
struct Gemm { const bf16_t* A; const bf16_t* Bt; int M, N, K; };

struct StaticOrder {
    int nM, nN, nwg, G, c;
    __host__ __device__ void init(int M, int N, int G_, int c_) { nM = M / BM; nN = N / BM; nwg = nM * nN; G = G_; c = c_; }
    __host__ __device__ bool next(int i, Unit& u) const {
        const long L = (long)i * G + c; if (L >= nwg) return false;
        int wgid = (int)L; { const int q = nwg / NXCD, r = nwg % NXCD, xcd = wgid % NXCD, off = wgid / NXCD; wgid = (xcd < r ? xcd * (q + 1) : r * (q + 1) + (xcd - r) * q) + off; }
        const int nig = WGM * nN, gid = wgid / nig, fm = gid * WGM, gsz = (nM - fm) < WGM ? (nM - fm) : WGM;
        u.pm = fm + ((wgid % nig) % gsz); u.pn = (wgid % nig) / gsz; return true;
    }
    __device__ __forceinline__ void a_ready(const Unit&) const {}
    __device__ __forceinline__ void done(const Unit&) const {}
};

__device__ __forceinline__ unsigned cvt_pk_bf16(float lo, float hi) { unsigned r; asm volatile("v_cvt_pk_bf16_f32 %0, %1, %2" : "=v"(r) : "v"(lo), "v"(hi)); return r; }
typedef float f32x2 __attribute__((ext_vector_type(2)));

struct EpiBf16 {
    static constexpr bool PERM = true, AFTER_DRAIN = false;
    bf16_t* O; int ldc;
    __device__ __forceinline__ void operator()(const f32x4 (&acc)[2][2][4][2], const Unit& u, int wr, int wc, int fr, int fq) const {
        const int row0 = u.pm * BM + wr * 64 + fr; const int col0 = u.pn * BM + wc * 32 + 8 * fq;
#pragma unroll
        for (int ai = 0; ai < 2; ++ai)
#pragma unroll
            for (int m = 0; m < 4; ++m) { bf16_t* rowp = O + (size_t)(row0 + ai * HALF + m * 16) * ldc + col0;
#pragma unroll
                for (int bj = 0; bj < 2; ++bj) { const f32x4 v0 = acc[ai][bj][m][0], v1 = acc[ai][bj][m][1];
                    u32x4 w; w.x = cvt_pk_bf16(v0[0], v0[1]); w.y = cvt_pk_bf16(v0[2], v0[3]); w.z = cvt_pk_bf16(v1[0], v1[1]); w.w = cvt_pk_bf16(v1[2], v1[3]);
                    *(u32x4*)(rowp + bj * HALF) = w; } }
    }
};
struct EpiResF32 {
    static constexpr bool PERM = false, AFTER_DRAIN = false;
    const float* base; float* out; int ldc;
    __device__ __forceinline__ void operator()(const f32x4 (&acc)[2][2][4][2], const Unit& u, int wr, int wc, int fr, int fq) const {
        const int row0 = u.pm * BM + wr * 64 + fr; const int col0 = u.pn * BM + wc * 32 + 4 * fq;
#pragma unroll
        for (int ai = 0; ai < 2; ++ai)
#pragma unroll
            for (int m = 0; m < 4; ++m) { const size_t off = (size_t)(row0 + ai * HALF + m * 16) * ldc + col0;
#pragma unroll
                for (int bj = 0; bj < 2; ++bj)
#pragma unroll
                    for (int n = 0; n < 2; ++n) { const f32x4 bs = *(const f32x4*)(base + off + bj * HALF + n * 16); *(f32x4*)(out + off + bj * HALF + n * 16) = bs + acc[ai][bj][m][n]; } }
    }
};
template <class Epi, class Sched, bool ALIGN_EPI = false, bool SP2 = false>
__device__ __forceinline__ void gemm_phase(PG8_LAS unsigned char* lds, const Gemm g, const Sched& S, const Epi& E) {
    const int tid = threadIdx.x, wid = __builtin_amdgcn_readfirstlane(tid >> 6), lane = tid & 63, wr = wid >> 2, wc = wid & 3, fr = lane & 15, fq = lane >> 4;
    const int K = g.K, nt = K / BK;
    unsigned voffA[2], voffB[2];
#pragma unroll
    for (int i = 0; i < 2; ++i) { int R, C; stage_rc(tid * 16 + i * 8192, R, C); const int Rb = Epi::PERM ? ((R & ~31) + perm32(R & 31)) : R;
        voffA[i] = (unsigned)(R * K + C) * 2u; voffB[i] = (unsigned)(Rb * K + C) * 2u; }
    const size_t kstep = (size_t)(BK * 2);
    const size_t hstep = (size_t)HALF * K * 2;
    const size_t tstep = 2 * hstep;
    const unsigned ldsw = (unsigned)wid * 1024u;
    const int aoff = lds_byte(wr * 64 + fr, fq * 8), boff = lds_byte(wc * 32 + fr, fq * 8);
#define PG8_SA(b, h) (((b) * 2 + (h)) * HTB)
#define PG8_SB(b, h) ((4 + (b) * 2 + (h)) * HTB)
#define PG8_STAGE(bufoff, gbase, voff) do { _Pragma("unroll") for (int _i = 0; _i < 2; ++_i) \
        __builtin_amdgcn_global_load_lds((const unsigned*)((const char*)(gbase) + (voff)[_i]), (PG8_LAS unsigned*)(lds + (bufoff) + ldsw + _i * 8192), 16, 0, 0); } while (0)
#define PG8_LDA(dst, b, h) do { _Pragma("unroll") for (int m = 0; m < 4; ++m) _Pragma("unroll") for (int k = 0; k < 2; ++k) dst[m][k] = *(const PG8_LAS bf16x8*)(lds + PG8_SA(b, h) + aoff + m * 2048 + k * 1024); } while (0)
#define PG8_LDB(dst, b, h) do { _Pragma("unroll") for (int n = 0; n < 2; ++n) _Pragma("unroll") for (int k = 0; k < 2; ++k) dst[n][k] = *(const PG8_LAS bf16x8*)(lds + PG8_SB(b, h) + boff + n * 2048 + k * 1024); } while (0)
#define PG8_MMA(ai, bj, At, Bt) do { __builtin_amdgcn_s_setprio(1); _Pragma("unroll") for (int m = 0; m < 4; ++m) _Pragma("unroll") for (int n = 0; n < 2; ++n) _Pragma("unroll") for (int k = 0; k < 2; ++k) \
        acc[ai][bj][m][n] = __builtin_amdgcn_mfma_f32_16x16x32_bf16(Bt[n][k], At[m][k], acc[ai][bj][m][n], 0, 0, 0); __builtin_amdgcn_s_setprio(0); } while (0)
#define PG8_WAIT_V(n) asm volatile("s_waitcnt vmcnt(" #n ")" ::: "memory")
#define PG8_WAIT_L(n) asm volatile("s_waitcnt lgkmcnt(" #n ")" ::: "memory")
#define PG8_BAR __builtin_amdgcn_s_barrier()
#define PG8_SCHED __builtin_amdgcn_sched_barrier(0)
    Unit cur, nxt; int ui = 0;
    if (!S.next(0, cur)) return;
    f32x4 acc[2][2][4][2];
#pragma unroll
    for (int a = 0; a < 2; ++a)
#pragma unroll
        for (int b = 0; b < 2; ++b)
#pragma unroll
            for (int m = 0; m < 4; ++m)
#pragma unroll
                for (int n = 0; n < 2; ++n) acc[a][b][m][n] = (f32x4){0.f, 0.f, 0.f, 0.f};
    bf16x8 At[4][2], B0[2][2], B1[2][2];
    const char* cA = (const char*)g.A + (size_t)cur.pm * tstep; const char* cB = (const char*)g.Bt + (size_t)cur.pn * tstep;
    S.a_ready(cur);
    if constexpr (SP2) {
        PG8_STAGE(PG8_SB(0, 0), cB, voffB); PG8_STAGE(PG8_SB(0, 1), cB + hstep, voffB); PG8_STAGE(PG8_SA(0, 0), cA, voffA); PG8_STAGE(PG8_SA(0, 1), cA + hstep, voffA);
        if (wr == 1) PG8_BAR;
        PG8_WAIT_V(2); PG8_BAR;
        PG8_STAGE(PG8_SB(1, 0), cB + kstep, voffB); PG8_STAGE(PG8_SA(1, 0), cA + kstep, voffA); PG8_STAGE(PG8_SB(1, 1), cB + hstep + kstep, voffB);
        PG8_WAIT_V(6); PG8_BAR;
    } else {
        PG8_STAGE(PG8_SB(0, 0), cB, voffB); PG8_STAGE(PG8_SA(0, 0), cA, voffA); PG8_STAGE(PG8_SB(0, 1), cB + hstep, voffB); PG8_STAGE(PG8_SA(0, 1), cA + hstep, voffA);
        if (wr == 1) PG8_BAR;
        PG8_WAIT_V(4); PG8_BAR;
        PG8_STAGE(PG8_SB(1, 0), cB + kstep, voffB); PG8_STAGE(PG8_SA(1, 0), cA + kstep, voffA); PG8_STAGE(PG8_SB(1, 1), cB + hstep + kstep, voffB);
        PG8_WAIT_V(6); PG8_BAR;
    }
    for (;;) {
        const bool has_next = S.next(ui + 1, nxt);
        const char* nA = has_next ? (const char*)g.A + (size_t)nxt.pm * tstep : cA; const char* nB = has_next ? (const char*)g.Bt + (size_t)nxt.pn * tstep : cB;
        for (int t = 0; t < nt; t += 2) {
            const bool last = (t == nt - 2);
            const char* a1 = cA + (size_t)(t + 1) * kstep;
            const char* a2 = last ? nA : cA + (size_t)(t + 2) * kstep; const char* b2 = last ? nB : cB + (size_t)(t + 2) * kstep;
            const char* a3 = a2 + kstep; const char* b3 = b2 + kstep;
            if (last && has_next) S.a_ready(nxt);
            if constexpr (SP2) {
            PG8_LDB(B0, 0, 0); PG8_LDB(B1, 0, 1); PG8_SCHED; PG8_LDA(At, 0, 0); PG8_STAGE(PG8_SA(1, 1), a1 + hstep, voffA);
            PG8_WAIT_V(8); PG8_WAIT_L(0); PG8_BAR; PG8_MMA(0, 0, At, B0); PG8_MMA(0, 1, At, B1); PG8_BAR; PG8_SCHED;
            PG8_LDA(At, 0, 1); PG8_STAGE(PG8_SB(0, 0), b2, voffB); PG8_STAGE(PG8_SB(0, 1), b2 + hstep, voffB); PG8_STAGE(PG8_SA(0, 0), a2, voffA);
            PG8_WAIT_V(8); PG8_WAIT_L(0); PG8_BAR; PG8_MMA(1, 0, At, B0); PG8_MMA(1, 1, At, B1); PG8_BAR; PG8_SCHED;
            PG8_LDB(B0, 1, 0); PG8_LDB(B1, 1, 1); PG8_SCHED; PG8_LDA(At, 1, 0); PG8_STAGE(PG8_SA(0, 1), a2 + hstep, voffA);
            PG8_WAIT_V(8); PG8_WAIT_L(0); PG8_BAR; PG8_MMA(0, 0, At, B0); PG8_MMA(0, 1, At, B1); PG8_BAR; PG8_SCHED;
            PG8_LDA(At, 1, 1); PG8_STAGE(PG8_SB(1, 0), b3, voffB); PG8_STAGE(PG8_SB(1, 1), b3 + hstep, voffB); PG8_STAGE(PG8_SA(1, 0), a3, voffA);
            PG8_WAIT_V(8); PG8_WAIT_L(0); PG8_BAR; PG8_MMA(1, 0, At, B0); PG8_MMA(1, 1, At, B1); PG8_BAR; PG8_SCHED;
            } else {
            PG8_LDB(B0, 0, 0); PG8_SCHED; PG8_LDA(At, 0, 0); PG8_STAGE(PG8_SA(1, 1), a1 + hstep, voffA);
            PG8_WAIT_L(8); PG8_BAR; PG8_WAIT_L(0); PG8_MMA(0, 0, At, B0); PG8_BAR; PG8_SCHED;
            PG8_LDB(B1, 0, 1); PG8_STAGE(PG8_SB(0, 0), b2, voffB);
            PG8_BAR; PG8_WAIT_L(0); PG8_MMA(0, 1, At, B1); PG8_BAR;
            PG8_LDA(At, 0, 1); PG8_STAGE(PG8_SA(0, 0), a2, voffA);
            PG8_BAR; PG8_WAIT_L(0); PG8_MMA(1, 0, At, B0); PG8_BAR; PG8_SCHED;
            PG8_STAGE(PG8_SB(0, 1), b2 + hstep, voffB);
            PG8_WAIT_V(6); PG8_BAR; PG8_MMA(1, 1, At, B1); PG8_BAR;
            PG8_LDB(B0, 1, 0); PG8_SCHED; PG8_LDA(At, 1, 0); PG8_STAGE(PG8_SA(0, 1), a2 + hstep, voffA);
            PG8_WAIT_L(8); PG8_BAR; PG8_WAIT_L(0); PG8_MMA(0, 0, At, B0); PG8_BAR; PG8_SCHED;
            PG8_LDB(B1, 1, 1); PG8_STAGE(PG8_SB(1, 0), b3, voffB);
            PG8_BAR; PG8_WAIT_L(0); PG8_MMA(0, 1, At, B1); PG8_BAR;
            PG8_LDA(At, 1, 1); PG8_STAGE(PG8_SA(1, 0), a3, voffA);
            PG8_BAR; PG8_WAIT_L(0); PG8_MMA(1, 0, At, B0); PG8_BAR; PG8_SCHED;
            PG8_STAGE(PG8_SB(1, 1), b3 + hstep, voffB);
            PG8_WAIT_V(6); PG8_BAR; PG8_MMA(1, 1, At, B1); PG8_BAR;
            }
        }
        if constexpr (ALIGN_EPI) { if (wr == 0) PG8_BAR; }
        if constexpr (!Epi::AFTER_DRAIN) { E(acc, cur, wr, wc, fr, fq); S.done(cur); }
        if (!has_next) break;
#pragma unroll
        for (int a = 0; a < 2; ++a)
#pragma unroll
            for (int b = 0; b < 2; ++b)
#pragma unroll
                for (int m = 0; m < 4; ++m)
#pragma unroll
                    for (int n = 0; n < 2; ++n) acc[a][b][m][n] = (f32x4){0.f, 0.f, 0.f, 0.f};
        cur = nxt; cA = nA; cB = nB; ++ui;
        if constexpr (ALIGN_EPI) { if (wr == 1) PG8_BAR; }
    }
    PG8_WAIT_V(0);
    if constexpr (!ALIGN_EPI) { if (wr == 0) PG8_BAR; }
    PG8_BAR;
    if constexpr (Epi::AFTER_DRAIN) { E.fused(acc, cur, wr, wc, fr, fq, lds, wid, lane); S.done(cur); }
#undef PG8_SA
#undef PG8_SB
#undef PG8_STAGE
#undef PG8_LDA
#undef PG8_LDB
#undef PG8_MMA
#undef PG8_WAIT_V
#undef PG8_WAIT_L
#undef PG8_BAR
#undef PG8_SCHED
}
}

#define GAS __attribute__((address_space(1)))
#define LAS __attribute__((address_space(3)))
typedef unsigned short bf16;
typedef unsigned v4u __attribute__((ext_vector_type(4)));
typedef float f32x4 __attribute__((ext_vector_type(4)));
typedef short bf16x8 __attribute__((ext_vector_type(8)));
typedef GAS unsigned gu32;
typedef GAS unsigned long long gu64;
#define RLX_AGENT __ATOMIC_RELAXED, __HIP_MEMORY_SCOPE_AGENT
#define LDS_WAIT() asm volatile("s_waitcnt lgkmcnt(0)" ::: "memory")
#define VM_WAIT() asm volatile("s_waitcnt vmcnt(0)" ::: "memory")
__device__ __forceinline__ unsigned long long rt() { return __builtin_amdgcn_s_memrealtime(); }
__device__ __forceinline__ unsigned f2bf(float f) { unsigned u = __builtin_bit_cast(unsigned, f); return (u + 0x7fffu + ((u >> 16) & 1u)) >> 16; }
__device__ __forceinline__ unsigned pk2(float lo, float hi) { return f2bf(lo) | (f2bf(hi) << 16); }


#define XB_TMO      128
#define XB_XCNT(j)  (256  + 64 * (j))
#define XB_XSUB(j)  (1280 + 64 * (j))
#define XB_XGEN(j)  (2304 + 64 * (j))
#define XB_TOP      3328
#define XB_TOPGEN   3392
#define XCD_BAR_WORDS 3456
#define XB_SPIN_CAP (1u << 18)

__device__ __forceinline__ unsigned xb_ld(unsigned* p)              { return __hip_atomic_load(p, __ATOMIC_RELAXED, __HIP_MEMORY_SCOPE_AGENT); }
__device__ __forceinline__ unsigned xb_add(unsigned* p, unsigned v) { return __hip_atomic_fetch_add(p, v, __ATOMIC_RELAXED, __HIP_MEMORY_SCOPE_AGENT); }
__device__ __forceinline__ unsigned xb_xcc_id() { return (unsigned)__builtin_amdgcn_s_getreg((3 << 11) | 20) & 0xFu; }
#define XB_SPIN(cond, bar) do { unsigned _sp = 0; while (cond) { __builtin_amdgcn_s_sleep(1); \
    if ((++_sp & 255u) == 0u) { if (xb_ld(&(bar)[XB_TMO])) break; if (_sp > XB_SPIN_CAP) { atomicAdd(&(bar)[XB_TMO], 1u); break; } } } } while (0)

struct XcdBarrier {
    unsigned* bar; unsigned x;
    volatile LAS unsigned* st;
};

__device__ __forceinline__ XcdBarrier xcd_barrier_post(unsigned* bar, volatile LAS unsigned* st) {
    XcdBarrier b; b.bar = bar; b.x = xb_xcc_id(); b.st = st;
    if (threadIdx.x == 0) (void)xb_add(&bar[XB_XCNT(b.x)], 1u);
    return b;
}
__device__ __forceinline__ void xcd_barrier_complete(unsigned* bar, unsigned x, unsigned& nloc, unsigned& nx) {
    const unsigned G = gridDim.x * gridDim.y * gridDim.z;
    unsigned sum, cnt, mine, sp = 0u;
    for (;;) {
        sum = 0u; cnt = 0u; mine = 0u;
#pragma unroll
        for (unsigned j = 0; j < 16; ++j) { const unsigned c = xb_ld(&bar[XB_XCNT(j)]); sum += c; cnt += (c > 0u) ? 1u : 0u; mine = (j == x) ? c : mine; }
        if (sum == G) break;
        __builtin_amdgcn_s_sleep(1);
        if ((++sp & 255u) == 0u) { if (xb_ld(&bar[XB_TMO])) break; if (sp > XB_SPIN_CAP) { atomicAdd(&bar[XB_TMO], 1u); break; } }
    }
    nloc = mine > 0u ? mine : 1u; nx = cnt > 0u ? cnt : 1u;
}

__device__ __forceinline__ void xcd_barrier(const XcdBarrier& b) {
    asm volatile("s_waitcnt vmcnt(0)" ::: "memory");
    __syncthreads();
    if (threadIdx.x == 0) {
        unsigned* bar = b.bar;
        __builtin_amdgcn_s_waitcnt(0);
        unsigned nloc = b.st[0], nx = b.st[1];
        if (nloc == 0u) { xcd_barrier_complete(bar, b.x, nloc, nx); b.st[0] = nloc; b.st[1] = nx; }
        const unsigned old = xb_add(&bar[XB_XSUB(b.x)], 1u);
        const unsigned gen = old / nloc;
        if (old + 1u == (gen + 1u) * nloc) {
            __builtin_amdgcn_fence(__ATOMIC_RELEASE, "agent");
            asm volatile("s_waitcnt vmcnt(0)" ::: "memory");
            const unsigned og = xb_add(&bar[XB_TOP], 1u);
            const unsigned tg = og / nx;
            if (og + 1u == (tg + 1u) * nx) xb_add(&bar[XB_TOPGEN], 1u);
            else XB_SPIN(xb_ld(&bar[XB_TOPGEN]) == tg, bar);
            __builtin_amdgcn_fence(__ATOMIC_ACQUIRE, "agent");
            xb_add(&bar[XB_XGEN(b.x)], 1u);
            asm volatile("s_waitcnt vmcnt(0)" ::: "memory");
        } else {
            XB_SPIN(xb_ld(&bar[XB_XGEN(b.x)]) == gen, bar);
            __builtin_amdgcn_fence(__ATOMIC_ACQUIRE, "agent");
            asm volatile("s_waitcnt vmcnt(0)" ::: "memory");
        }
    }
    __syncthreads();
}

constexpr int NWAVES = 8, NTHR = 512;
constexpr int SEQ = 8192, DM = 2048, DIN = 6528, NPAD = 6656, ZLD = 6656;
constexpr int C_R = 0, C_K = 1024, C_V = 2048, C_G = 3072, C_WL = 4096, C_AL = 4160, C_Q = 4224, C_AK = 5248, C_AV = 5376, C_AG = 5504;
constexpr int NH = 16, HD = 64, DR = 1024;
#ifndef MK_FUSED
#define MK_FUSED 1
#endif
constexpr int N_PHASES = 6;
constexpr size_t MiB = 1u << 20;
constexpr size_t WS_CTL = 0, CTL_ZERO_BYTES = 1 * MiB;
constexpr size_t WS_WTOUT = 1 * MiB;
constexpr size_t WS_Z = 9 * MiB;
constexpr size_t WS_H = 113 * MiB;
constexpr size_t WS_WTIN = 145 * MiB;
constexpr size_t WS_PF = 145 * MiB, WS_QF = 161 * MiB, WS_RHF = 177 * MiB, WS_OIF = 193 * MiB, WS_SF = 209 * MiB;
constexpr size_t WS_VT = 225 * MiB;
constexpr size_t WS_BS = 227 * MiB;
constexpr size_t WS_W2T = 240 * MiB, WS_A2T = 241 * MiB;
constexpr size_t WS_END = 256 * MiB;
constexpr int CW_BAR = 4096;
constexpr int RING_BYTES = 131072, LDSCTL_OFF = RING_BYTES, MISC_OFF = LDSCTL_OFF + 320, LDS_BYTES = 147456;

struct Frame {
    LAS unsigned char* lds;
    volatile LAS unsigned* MISC;
    gu32* ctl;
    int tid, lane, wave, vcu, G;
};
struct Args { const float* in[18]; float* out; unsigned char* ws; int ph_lo, ph_hi; };

__device__ __forceinline__ float wave_sum(float v) {
#pragma unroll
    for (int o = 1; o < 64; o <<= 1) v += __shfl_xor(v, o);
    return v;
}
__device__ __forceinline__ float bf2f(bf16 b) { return __builtin_bit_cast(float, (unsigned)b << 16); }
__device__ __forceinline__ float bflo(unsigned w) { return __builtin_bit_cast(float, w << 16); }
__device__ __forceinline__ float bfhi(unsigned w) { return __builtin_bit_cast(float, w & 0xffff0000u); }

__device__ __forceinline__ void p0_transpose_item(const float* W, int K, int N, bf16* WT, LAS float* scr, int item, int lane) {
    const int nblk = N / 32, kb = item / nblk, nb = item % nblk, k0 = 64 * kb, n0 = 32 * nb;
#pragma unroll 8
    for (int i = 0; i < 32; ++i) { const int kk = 2 * i + (lane >> 5); scr[kk * 33 + (lane & 31)] = W[(size_t)(k0 + kk) * N + n0 + (lane & 31)]; }
    LDS_WAIT(); asm volatile("" ::: "memory");
    const int c = lane & 7;
#pragma unroll
    for (int j = 0; j < 4; ++j) { const int n = (lane >> 3) + 8 * j; const LAS float* s = scr + (8 * c) * 33 + n;
        v4u o; o.x = pk2(s[0 * 33], s[1 * 33]); o.y = pk2(s[2 * 33], s[3 * 33]); o.z = pk2(s[4 * 33], s[5 * 33]); o.w = pk2(s[6 * 33], s[7 * 33]);
        *(GAS v4u*)(WT + (size_t)(n0 + n) * K + k0 + 8 * c) = o; }
    LDS_WAIT(); asm volatile("" ::: "memory");
}

__device__ __forceinline__ void p0_prologue(Frame& F, const Args& a, unsigned char* ws) {
    const float* x = a.in[0]; const float* norm_w = a.in[1]; const float* w_in = a.in[2]; const float* w_out = a.in[3];
    bf16* WTIN = (bf16*)(ws + WS_WTIN); bf16* WTOUT = (bf16*)(ws + WS_WTOUT); bf16* H = (bf16*)(ws + WS_H);
    LAS float* scr = (LAS float*)(F.lds + F.wave * 16384);
    const int gw = F.vcu * NWAVES + F.wave, NGW = F.G * NWAVES;
    constexpr int I_IN = (DM / 64) * (DIN / 32), I_OUT = (DM / 64) * (DM / 32);
    for (int it = gw; it < I_IN + I_OUT; it += NGW) {
        if (it < I_IN) p0_transpose_item(w_in, DM, DIN, WTIN, scr, it, F.lane);
        else p0_transpose_item(w_out, DM, DM, WTOUT, scr, it - I_IN, F.lane);
    }
    { GAS v4u* p = (GAS v4u*)(WTIN + (size_t)DIN * DM); const int n16 = (NPAD - DIN) * DM * 2 / 16;
      for (int i = blockIdx.x * NTHR + F.tid; i < n16; i += F.G * NTHR) p[i] = (v4u){0u, 0u, 0u, 0u}; }
    { bf16* W2T = (bf16*)(ws + WS_W2T); bf16* A2T = (bf16*)(ws + WS_A2T); const float* w2 = a.in[6]; const float* a2 = a.in[8];
      for (int i = blockIdx.x * NTHR + F.tid; i < 16 * 64 * 64; i += F.G * NTHR) { const int j = i & 63, hk = i >> 6;
          W2T[i] = (bf16)f2bf(w2[j * DR + hk]); A2T[i] = (bf16)f2bf(a2[j * DR + hk]); } }
    for (int m = gw; m < SEQ; m += NGW) {
        const GAS f32x4* xr = (const GAS f32x4*)(x + (size_t)m * DM) + F.lane;
        f32x4 v[8]; float s = 0.f;
#pragma unroll
        for (int j = 0; j < 8; ++j) { v[j] = xr[64 * j]; s += (v[j].x * v[j].x + v[j].y * v[j].y) + (v[j].z * v[j].z + v[j].w * v[j].w); }
        const float rstd = 1.0f / sqrtf(wave_sum(s) * (1.f / DM) + 1e-6f);
        GAS unsigned long long* o8 = (GAS unsigned long long*)(H + (size_t)m * DM) + F.lane;
        const GAS f32x4* nw = (const GAS f32x4*)norm_w + F.lane;
#pragma unroll
        for (int j = 0; j < 8; ++j) { const f32x4 g = nw[64 * j];
            o8[64 * j] = (unsigned long long)pk2(v[j].x * rstd * g.x, v[j].y * rstd * g.y) | ((unsigned long long)pk2(v[j].z * rstd * g.z, v[j].w * rstd * g.w) << 32); }
    }
}

__device__ __forceinline__ void p2_attn_prep(Frame& F, const Args& a, unsigned char* ws) {
    bf16* Z = (bf16*)(ws + WS_Z); bf16* VT = (bf16*)(ws + WS_VT);
    const float* qnw = a.in[14]; const float* knw = a.in[15];
    const int tid = F.tid, lane = F.lane, wave = F.wave;
    for (int it = blockIdx.x; it < SEQ / 8; it += F.G) {
        const int t0 = it * 8;
        for (int hv = wave; hv < 8 * 18; hv += NWAVES) {
            const int tok = hv / 18, hh = hv % 18, t = t0 + tok;
            const int col = hh < 16 ? C_Q + hh * 64 : C_AK + (hh - 16) * 64;
            bf16* p = Z + (size_t)t * ZLD + col + lane;
            const float v = bf2f(*p);
            const float ss = wave_sum(v * v);
            const float rstd = 1.0f / sqrtf(ss * (1.f / 64.f) + 1e-6f);
            const float g = hh < 16 ? qnw[lane] * 0.125f : knw[lane];
            *p = (bf16)f2bf(v * rstd * g);
        }
        { const int dcol = tid & 127, tp = tid >> 7, t = t0 + 2 * tp;
          const unsigned lo = Z[(size_t)t * ZLD + C_AV + dcol], hi = Z[(size_t)(t + 1) * ZLD + C_AV + dcol];
          *(unsigned*)(VT + (size_t)dcol * SEQ + t) = lo | (hi << 16); }
    }
}

typedef float f32x16 __attribute__((ext_vector_type(16)));
typedef unsigned u32x4 __attribute__((ext_vector_type(4)));
typedef unsigned u32x2 __attribute__((ext_vector_type(2)));
__device__ __forceinline__ void p3_attn(Frame& F, const Args& a, unsigned char* ws, int ablk, int nablk) {
    const bf16* Z = (const bf16*)(ws + WS_Z); const bf16* VT = (const bf16*)(ws + WS_VT); bf16* Y = (bf16*)(ws + WS_H);
    const float* sinks = a.in[16]; const float* rel_bias = a.in[17];
    LAS float* tb = (LAS float*)F.lds;
    for (int i = F.tid; i < 16 * 128; i += NTHR) { const int h = i >> 7, d = i & 127;
        int b; if (d < 16) b = d; else { b = 16 + (int)(logf((float)d * (1.f / 16.f)) / logf(8.f) * 16.f); if (b > 31) b = 31; }
        tb[i] = rel_bias[b * 16 + h]; }
    __syncthreads();
    const int lane = F.lane, r = lane & 31, h = lane >> 5;
    for (int item = ablk * NWAVES + F.wave; item < 64 * 16 * 4; item += nablk * NWAVES) {
        const int slab = item & 3, hq = (item >> 2) & 15, nb = item >> 6, hk = hq >> 3;
        const int q0 = nb * 128 + slab * 32;
        bf16x8 qf[4];
#pragma unroll
        for (int s = 0; s < 4; ++s) qf[s] = *(const bf16x8*)(Z + (size_t)(q0 + r) * ZLD + C_Q + hq * 64 + 16 * s + 8 * h);
        f32x16 st[5];
        const LAS float* tbh = tb + hq * 128;
        float mx = sinks[hq];
#pragma unroll
        for (int tt = 0; tt < 5; ++tt) {
            const int jb = q0 - 128 + 32 * tt; int kt = jb + r; if (kt < 0) kt = 0;
            f32x16 acc = (f32x16){0.f,0.f,0.f,0.f,0.f,0.f,0.f,0.f,0.f,0.f,0.f,0.f,0.f,0.f,0.f,0.f};
#pragma unroll
            for (int s = 0; s < 4; ++s) { const bf16x8 kf = *(const bf16x8*)(Z + (size_t)kt * ZLD + C_AK + hk * 64 + 16 * s + 8 * h);
                acc = __builtin_amdgcn_mfma_f32_32x32x16_bf16(kf, qf[s], acc, 0, 0, 0); }
#pragma unroll
            for (int g = 0; g < 16; ++g) { const int jj = 8 * (g >> 2) + 4 * h + (g & 3); const int dist = 128 - 32 * tt + r - jj;
                const bool ok = dist >= 0 && dist < 128 && (jb + jj) >= 0;
                const float v = ok ? acc[g] + tbh[dist & 127] : -INFINITY;
                st[tt][g] = v; mx = fmaxf(mx, v); }
        }
        mx = fmaxf(mx, __shfl_xor(mx, 32));
        float sum = 0.f;
#pragma unroll
        for (int tt = 0; tt < 5; ++tt)
#pragma unroll
            for (int g = 0; g < 16; ++g) { const float e = __expf(st[tt][g] - mx); st[tt][g] = e; sum += e; }
        sum += __shfl_xor(sum, 32);
        sum += __expf(sinks[hq] - mx);
        const float inv = 1.0f / sum;
        f32x16 o0 = (f32x16){0.f,0.f,0.f,0.f,0.f,0.f,0.f,0.f,0.f,0.f,0.f,0.f,0.f,0.f,0.f,0.f}, o1 = o0;
#pragma unroll
        for (int tt = 0; tt < 5; ++tt) {
            const int jb = q0 - 128 + 32 * tt;
#pragma unroll
            for (int s2 = 0; s2 < 2; ++s2) {
                u32x4 pw; pw.x = pk2(st[tt][8 * s2 + 0], st[tt][8 * s2 + 1]); pw.y = pk2(st[tt][8 * s2 + 2], st[tt][8 * s2 + 3]); pw.z = pk2(st[tt][8 * s2 + 4], st[tt][8 * s2 + 5]); pw.w = pk2(st[tt][8 * s2 + 6], st[tt][8 * s2 + 7]);
                const bf16x8 pf = __builtin_bit_cast(bf16x8, pw);
                int k0 = jb + 16 * s2 + 4 * h; int k1 = k0 + 8; if (k0 < 0) k0 = 0; if (k1 < 0) k1 = 0;
#pragma unroll
                for (int dt = 0; dt < 2; ++dt) { const bf16* vrow = VT + (size_t)(hk * 64 + 32 * dt + r) * SEQ;
                    const u32x2 lo = *(const u32x2*)(vrow + k0), hi = *(const u32x2*)(vrow + k1);
                    u32x4 vw; vw.x = lo.x; vw.y = lo.y; vw.z = hi.x; vw.w = hi.y;
                    const bf16x8 vf = __builtin_bit_cast(bf16x8, vw);
                    if (dt == 0) o0 = __builtin_amdgcn_mfma_f32_32x32x16_bf16(vf, pf, o0, 0, 0, 0); else o1 = __builtin_amdgcn_mfma_f32_32x32x16_bf16(vf, pf, o1, 0, 0, 0); }
            }
        }
        const int t = q0 + r;
#pragma unroll
        for (int dt = 0; dt < 2; ++dt)
#pragma unroll
            for (int g4 = 0; g4 < 4; ++g4) { const int d = 32 * dt + 8 * g4 + 4 * h;
                const u32x2 gw = *(const u32x2*)(Z + (size_t)t * ZLD + C_AG + hq * 64 + d);
                const float g0 = bflo(gw.x), g1 = bfhi(gw.x), g2 = bflo(gw.y), g3 = bfhi(gw.y);
                const f32x16& oo = dt == 0 ? o0 : o1;
                const float y0 = oo[4 * g4 + 0] * inv * g0 / (1.f + __expf(-g0)), y1 = oo[4 * g4 + 1] * inv * g1 / (1.f + __expf(-g1));
                const float y2 = oo[4 * g4 + 2] * inv * g2 / (1.f + __expf(-g2)), y3 = oo[4 * g4 + 3] * inv * g3 / (1.f + __expf(-g3));
                u32x2 w; w.x = pk2(y0, y1); w.y = pk2(y2, y3);
                *(u32x2*)(Y + (size_t)t * DM + 1024 + hq * 64 + d) = w; }
    }
}

typedef float f32x2_t __attribute__((ext_vector_type(2))); typedef __bf16 bf16x2_t __attribute__((ext_vector_type(2)));
__device__ __forceinline__ unsigned cvtpk(float lo, float hi) { f32x2_t v = {lo, hi}; bf16x2_t b = __builtin_convertvector(v, bf16x2_t); return __builtin_bit_cast(unsigned, b); }
constexpr int LDM = 72;
constexpr int MB = 64 * LDM * 2;
constexpr int WFS = 68;
#define MFMA16(a, b, c) __builtin_amdgcn_mfma_f32_16x16x32_bf16(a, b, c, 0, 0, 0)
__device__ __forceinline__ bf16x8 ldfrag(const LAS bf16* M, int row0, int ks, int lane) {
    return *(const LAS bf16x8*)(M + (row0 + (lane & 15)) * LDM + 32 * ks + 8 * (lane >> 4));
}
__device__ __forceinline__ f32x4 mm_tile(const LAS bf16* X, int m0, const LAS bf16* Y, int n0, f32x4 acc, int lane) {
    acc = MFMA16(ldfrag(X, m0, 0, lane), ldfrag(Y, n0, 0, lane), acc);
    acc = MFMA16(ldfrag(X, m0, 1, lane), ldfrag(Y, n0, 1, lane), acc);
    return acc;
}
__device__ __forceinline__ void st_T(LAS bf16* M, int m0, int n0, f32x4 acc, int lane) {
    u32x2 w; w.x = cvtpk(acc[0], acc[1]); w.y = cvtpk(acc[2], acc[3]);
    *(LAS u32x2*)(M + (n0 + (lane & 15)) * LDM + m0 + 4 * (lane >> 4)) = w;
}
__device__ __forceinline__ void st_N(LAS bf16* M, int m0, int n0, f32x4 acc, int lane) {
    const unsigned w0 = cvtpk(acc[0], acc[1]), w1 = cvtpk(acc[2], acc[3]);
    LAS bf16* p = M + (m0 + 4 * (lane >> 4)) * LDM + n0 + (lane & 15);
    p[0] = (bf16)(w0 & 0xffffu); p[LDM] = (bf16)(w0 >> 16); p[2 * LDM] = (bf16)(w1 & 0xffffu); p[3 * LDM] = (bf16)(w1 >> 16);
}
__device__ __forceinline__ f32x4 ld4bf(const LAS bf16* p) { const u32x2 w = *(const LAS u32x2*)p; return (f32x4){bflo(w.x), bfhi(w.x), bflo(w.y), bfhi(w.y)}; }
__device__ __forceinline__ void shift8(const bf16* Z, int tok, int col, const float* mu, float* o) {
    const v4u zc = *(const v4u*)(Z + (size_t)tok * ZLD + col);
    v4u zp = (v4u){0u, 0u, 0u, 0u}; if (tok > 0) zp = *(const v4u*)(Z + (size_t)(tok - 1) * ZLD + col);
    const f32x4 m0 = *(const f32x4*)(mu + col), m1 = *(const f32x4*)(mu + col + 4);
    float c_, p_;
    c_ = bflo(zc.x); p_ = bflo(zp.x); o[0] = c_ + (p_ - c_) * m0.x;  c_ = bfhi(zc.x); p_ = bfhi(zp.x); o[1] = c_ + (p_ - c_) * m0.y;
    c_ = bflo(zc.y); p_ = bflo(zp.y); o[2] = c_ + (p_ - c_) * m0.z;  c_ = bfhi(zc.y); p_ = bfhi(zp.y); o[3] = c_ + (p_ - c_) * m0.w;
    c_ = bflo(zc.z); p_ = bflo(zp.z); o[4] = c_ + (p_ - c_) * m1.x;  c_ = bfhi(zc.z); p_ = bfhi(zp.z); o[5] = c_ + (p_ - c_) * m1.y;
    c_ = bflo(zc.w); p_ = bflo(zp.w); o[6] = c_ + (p_ - c_) * m1.z;  c_ = bfhi(zc.w); p_ = bfhi(zp.w); o[7] = c_ + (p_ - c_) * m1.w;
}
__device__ __forceinline__ void shift4(const bf16* Z, int tok, int col, const float* mu, float* o) {
    const u32x2 zc = *(const u32x2*)(Z + (size_t)tok * ZLD + col);
    u32x2 zp = (u32x2){0u, 0u}; if (tok > 0) zp = *(const u32x2*)(Z + (size_t)(tok - 1) * ZLD + col);
    const f32x4 m0 = *(const f32x4*)(mu + col);
    float c_, p_;
    c_ = bflo(zc.x); p_ = bflo(zp.x); o[0] = c_ + (p_ - c_) * m0.x;  c_ = bfhi(zc.x); p_ = bfhi(zp.x); o[1] = c_ + (p_ - c_) * m0.y;
    c_ = bflo(zc.y); p_ = bflo(zp.y); o[2] = c_ + (p_ - c_) * m0.z;  c_ = bfhi(zc.y); p_ = bfhi(zp.y); o[3] = c_ + (p_ - c_) * m0.w;
}
__device__ __forceinline__ v4u pack8(const float* v) { v4u w; w.x = cvtpk(v[0], v[1]); w.y = cvtpk(v[2], v[3]); w.z = cvtpk(v[4], v[5]); w.w = cvtpk(v[6], v[7]); return w; }
#define BARRIER() __syncthreads()

__device__ __forceinline__ void pA_chunk(Frame& F, const Args& a, unsigned char* ws) {
    const bf16* Z = (const bf16*)(ws + WS_Z);
    bf16* PF = (bf16*)(ws + WS_PF); bf16* QF = (bf16*)(ws + WS_QF); bf16* RHF = (bf16*)(ws + WS_RHF); bf16* OIF = (bf16*)(ws + WS_OIF);
    float* BS = (float*)(ws + WS_BS);
    const bf16* W2T = (const bf16*)(ws + WS_W2T); const bf16* A2T = (const bf16*)(ws + WS_A2T);
    const float* mu = a.in[4]; const float* w0 = a.in[5]; const float* a0 = a.in[7];
    const float* k_k = a.in[9]; const float* k_a = a.in[10]; const float* r_k = a.in[11];
    LAS unsigned char* lds = F.lds;
#define LM(i) ((LAS bf16*)(lds + (i) * MB))
    LAS bf16* const mRT = LM(0); LAS bf16* const mBHT = LM(1); LAS bf16* const mKH = LM(2); LAS bf16* const mVVT = LM(3);
    LAS bf16* const mGH = LM(4);
    LAS bf16* const mBBRT = LM(6); LAS bf16* const mAT = LM(7); LAS bf16* const mBT = LM(8); LAS bf16* const mKT = LM(9);
    LAS bf16* const mA = LM(10); LAS bf16* const mAAT = LM(11); LAS bf16* const mS12 = LM(12);
    LAS bf16* const mTH = LM(7); LAS bf16* const mALM = LM(8);
    LAS float* const Wf = (LAS float*)(lds + 10 * MB);
    LAS float* const Af = (LAS float*)(lds + 12 * MB);
    LAS float* const GT = (LAS float*)(lds + 12 * MB + 64 * WFS * 4);
    LAS float* const CC = GT + 512;
    LAS bf16* const mZ1T = LM(9); LAS bf16* const mZ2T = LM(12);
    const int tid = F.tid, lane = F.lane, w = F.wave, q = lane >> 4, l15 = lane & 15;
    const int mi = w >> 1, nb = 2 * (w & 1);
    const int et = tid >> 3, oct = tid & 7;
    for (int item = blockIdx.x; item < 2048; item += F.G) {
        const int c = item >> 4, h = item & 15, T0 = c * 64, tok = T0 + et;
        const int chb = h * 64 + 8 * oct;
        BARRIER();
        float r8[8], k8[8], v8[8];
        { float wl8[8], al8[8];
          shift8(Z, tok, C_WL + 8 * oct, mu, wl8); shift8(Z, tok, C_AL + 8 * oct, mu, al8);
#pragma unroll
          for (int i = 0; i < 8; ++i) wl8[i] = 1.f - 2.f / (1.f + __expf(2.f * wl8[i]));
          *(LAS v4u*)(mTH + et * LDM + 8 * oct) = pack8(wl8); *(LAS v4u*)(mALM + et * LDM + 8 * oct) = pack8(al8); }
        shift8(Z, tok, C_R + chb, mu, r8); shift8(Z, tok, C_K + chb, mu, k8); shift8(Z, tok, C_V + chb, mu, v8);
        BARRIER();
#pragma unroll
        for (int nn = 0; nn < 2; ++nn) { const int n0 = 16 * (nb + nn);
            f32x4 aw = (f32x4){0.f, 0.f, 0.f, 0.f}, aa = aw;
#pragma unroll
            for (int ks = 0; ks < 2; ++ks) {
                const bf16x8 bw = *(const bf16x8*)(W2T + (size_t)(h * 64 + n0 + l15) * 64 + 32 * ks + 8 * q);
                const bf16x8 ba = *(const bf16x8*)(A2T + (size_t)(h * 64 + n0 + l15) * 64 + 32 * ks + 8 * q);
                aw = MFMA16(ldfrag(mTH, 16 * mi, ks, lane), bw, aw); aa = MFMA16(ldfrag(mALM, 16 * mi, ks, lane), ba, aa); }
#pragma unroll
            for (int rg = 0; rg < 4; ++rg) { Wf[(16 * mi + 4 * q + rg) * WFS + n0 + l15] = aw[rg]; Af[(16 * mi + 4 * q + rg) * WFS + n0 + l15] = aa[rg]; } }
        BARRIER();
        float logd[8], alr[8];
#pragma unroll
        for (int i = 0; i < 8; ++i) {
            const float nx = -(w0[chb + i] + Wf[et * WFS + 8 * oct + i]);
            const float sp = nx > 20.f ? nx : __logf(1.f + __expf(nx));
            logd[i] = -__expf(-sp - 0.5f);
            alr[i] = 1.f / (1.f + __expf(-(a0[chb + i] + Af[et * WFS + 8 * oct + i])));
            Wf[et * WFS + 8 * oct + i] = logd[i];
        }
        BARRIER();
        { const int g = tid >> 6, kc = tid & 63; float s = 0.f;
#pragma unroll
          for (int tt = 0; tt < 8; ++tt) { s += Wf[(8 * g + tt) * WFS + kc]; Wf[(8 * g + tt) * WFS + kc] = s; }
          GT[g * 64 + kc] = s; }
        BARRIER();
        { float cum[8], cC[8];
          { f32x4 offA = (f32x4){0.f, 0.f, 0.f, 0.f}, offB = offA, totA = offA, totB = offA;
#pragma unroll 2
            for (int g = 0; g < 8; ++g) { const f32x4 ga = *(const LAS f32x4*)(GT + g * 64 + 8 * oct), gb = *(const LAS f32x4*)(GT + g * 64 + 8 * oct + 4);
                totA += ga; totB += gb; if (g < (et >> 3)) { offA += ga; offB += gb; } }
            const f32x4 wa = *(const LAS f32x4*)(Wf + et * WFS + 8 * oct), wb = *(const LAS f32x4*)(Wf + et * WFS + 8 * oct + 4);
#pragma unroll
            for (int i = 0; i < 4; ++i) { cum[i] = wa[i] + offA[i]; cum[4 + i] = wb[i] + offB[i]; cC[i] = totA[i]; cC[4 + i] = totB[i]; } }
          float kk[8], km[8]; float n2 = 0.f, bsum = 0.f;
#pragma unroll
          for (int i = 0; i < 8; ++i) { kk[i] = k8[i] * k_k[chb + i]; n2 += kk[i] * kk[i]; km[i] = k8[i] * (1.f + (alr[i] - 1.f) * k_a[chb + i]); bsum += r8[i] * km[i] * r_k[chb + i]; }
          n2 += __shfl_xor(n2, 1); n2 += __shfl_xor(n2, 2); n2 += __shfl_xor(n2, 4);
          bsum += __shfl_xor(bsum, 1); bsum += __shfl_xor(bsum, 2); bsum += __shfl_xor(bsum, 4);
          const float rs = 1.0f / sqrtf(fmaxf(n2, 1e-24f));
          if (oct == 0) BS[(size_t)tok * 16 + h] = bsum;
          if (et == 0) {
#pragma unroll
              for (int i = 0; i < 8; ++i) CC[8 * oct + i] = cC[i]; }
          float vAt[8], vBt[8], vKt[8], vRt[8], vBh[8], vKh[8];
#pragma unroll
          for (int i = 0; i < 8; ++i) { kk[i] *= rs; const float bb = kk[i] * alr[i];
              const float e1 = __expf(cum[i] - logd[i]), e2 = __expf(-cum[i]), e3 = __expf(cum[i]), e4 = __expf(cC[i] - cum[i]);
              vAt[i] = -kk[i] * e1; vBt[i] = bb * e2; vKt[i] = km[i] * e2; vRt[i] = r8[i] * e3; vBh[i] = bb * e4; vKh[i] = km[i] * e4; }
          *(LAS v4u*)(mAT + et * LDM + 8 * oct) = pack8(vAt); *(LAS v4u*)(mBT + et * LDM + 8 * oct) = pack8(vBt); *(LAS v4u*)(mKT + et * LDM + 8 * oct) = pack8(vKt);
          *(LAS v4u*)(mRT + et * LDM + 8 * oct) = pack8(vRt); *(LAS v4u*)(mKH + et * LDM + 8 * oct) = pack8(vKh);
#pragma unroll
          for (int i = 0; i < 8; i += 2) { const unsigned wa = cvtpk(vAt[i], vAt[i + 1]), wb = cvtpk(vBh[i], vBh[i + 1]), wv = cvtpk(v8[i], v8[i + 1]);
              mGH[(8 * oct + i) * LDM + et] = (bf16)(wa & 0xffffu); mGH[(8 * oct + i + 1) * LDM + et] = (bf16)(wa >> 16);
              mBHT[(8 * oct + i) * LDM + et] = (bf16)(wb & 0xffffu); mBHT[(8 * oct + i + 1) * LDM + et] = (bf16)(wb >> 16);
              mVVT[(8 * oct + i) * LDM + et] = (bf16)(wv & 0xffffu); mVVT[(8 * oct + i + 1) * LDM + et] = (bf16)(wv >> 16); }
        }
        BARRIER();
        f32x4 ghG[2], ghH[2], bkr[2];
        const f32x4 zero4 = (f32x4){0.f, 0.f, 0.f, 0.f};
#pragma unroll
        for (int nn = 0; nn < 2; ++nn) { const int j0 = 16 * mi, t0 = 16 * (nb + nn);
            const bf16x8 fB0 = ldfrag(mBT, j0, 0, lane), fB1 = ldfrag(mBT, j0, 1, lane), fK0 = ldfrag(mKT, j0, 0, lane), fK1 = ldfrag(mKT, j0, 1, lane);
            const bf16x8 fA0 = ldfrag(mAT, t0, 0, lane), fA1 = ldfrag(mAT, t0, 1, lane), fR0 = ldfrag(mRT, t0, 0, lane), fR1 = ldfrag(mRT, t0, 1, lane);
            f32x4 dab = MFMA16(fB0, fA0, zero4); dab = MFMA16(fB1, fA1, dab);
            f32x4 dbr = MFMA16(fB0, fR0, zero4); dbr = MFMA16(fB1, fR1, dbr);
            f32x4 dkr = MFMA16(fK0, fR0, zero4); dkr = MFMA16(fK1, fR1, dkr);
            f32x4 dak = MFMA16(fA0, fK0, zero4); dak = MFMA16(fA1, fK1, dak);
#pragma unroll
            for (int rg = 0; rg < 4; ++rg) { const int jj = j0 + 4 * q + rg, tt = t0 + l15;
                if (!(jj < tt)) dab[rg] = 0.f; if (!(jj <= tt)) { dbr[rg] = 0.f; dkr[rg] = 0.f; }
                const int t2 = t0 + 4 * q + rg, j2 = j0 + l15; if (!(j2 < t2)) dak[rg] = 0.f; }
            st_N(mA, j0, t0, dab, lane); st_T(mAAT, j0, t0, dab, lane);
            st_T(mBBRT, j0, t0, dbr, lane);
            st_T(mGH + 64 * LDM, t0, j0, dak, lane);
            ghH[nn] = dak; bkr[nn] = dkr; }
        BARRIER();
#pragma unroll
        for (int nn = 0; nn < 2; ++nn) ghG[nn] = ld4bf(mGH + (16 * mi + l15) * LDM + 16 * (nb + nn) + 4 * q);
#pragma unroll 1
        for (int s = 0; s < 6; ++s) {
            LAS bf16* const cA = (s & 1) ? LM(7) : LM(10); LAS bf16* const cAT = (s & 1) ? LM(8) : LM(11);
            LAS bf16* const nA = (s & 1) ? LM(10) : LM(7); LAS bf16* const nAT = (s & 1) ? LM(11) : LM(8);
            f32x4 sq[2];
#pragma unroll
            for (int nn = 0; nn < 2; ++nn) { const int t0 = 16 * (nb + nn);
                const bf16x8 fT0 = ldfrag(cAT, t0, 0, lane), fT1 = ldfrag(cAT, t0, 1, lane);
                ghG[nn] = MFMA16(fT0, ldfrag(mGH, 16 * mi, 0, lane), ghG[nn]); ghG[nn] = MFMA16(fT1, ldfrag(mGH, 16 * mi, 1, lane), ghG[nn]);
                ghH[nn] = MFMA16(fT0, ldfrag(mGH, 64 + 16 * mi, 0, lane), ghH[nn]); ghH[nn] = MFMA16(fT1, ldfrag(mGH, 64 + 16 * mi, 1, lane), ghH[nn]);
                if (s < 5) { sq[nn] = MFMA16(ldfrag(cA, 16 * mi, 0, lane), fT0, zero4); sq[nn] = MFMA16(ldfrag(cA, 16 * mi, 1, lane), fT1, sq[nn]); } }
            BARRIER();
#pragma unroll
            for (int nn = 0; nn < 2; ++nn) { const int t0 = 16 * (nb + nn);
                st_T(mGH, t0, 16 * mi, ghG[nn], lane); st_T(mGH, t0, 64 + 16 * mi, ghH[nn], lane);
                if (s < 5) { st_N(nA, 16 * mi, t0, sq[nn], lane); st_T(nAT, 16 * mi, t0, sq[nn], lane); } }
            BARRIER();
        }
        { bf16* PFi = PF + (size_t)item * 4096; bf16* RHFi = RHF + (size_t)item * 4096;
          const int k0 = 16 * mi, ks_o = k0 >> 5, hb = 4 * ((k0 >> 4) & 1);
          const bf16x8 fG0 = ldfrag(mGH, k0, 0, lane), fG1 = ldfrag(mGH, k0, 1, lane), fH0 = ldfrag(mGH, 64 + k0, 0, lane), fH1 = ldfrag(mGH, 64 + k0, 1, lane);
#pragma unroll
          for (int nn = 0; nn < 2; ++nn) { const int n0 = 16 * (nb + nn), ni = nb + nn;
              const bf16x8 fBh0 = ldfrag(mBHT, n0, 0, lane), fBh1 = ldfrag(mBHT, n0, 1, lane), fBr0 = ldfrag(mBBRT, n0, 0, lane), fBr1 = ldfrag(mBBRT, n0, 1, lane);
              f32x4 dp = MFMA16(fG0, fBh0, zero4); dp = MFMA16(fG1, fBh1, dp);
#pragma unroll
              for (int rg = 0; rg < 4; ++rg) if (k0 + 4 * q + rg == n0 + l15) dp[rg] += __expf(CC[k0 + 4 * q + rg]);
              { u32x2 wv; wv.x = cvtpk(dp[0], dp[1]); wv.y = cvtpk(dp[2], dp[3]); *(u32x2*)(PFi + ((ni * 2 + ks_o) * 64 + lane) * 8 + hb) = wv; }
              f32x4 dr = ld4bf(mRT + (n0 + l15) * LDM + k0 + 4 * q);
              dr = MFMA16(fG0, fBr0, dr); dr = MFMA16(fG1, fBr1, dr);
              { u32x2 wv; wv.x = cvtpk(dr[0], dr[1]); wv.y = cvtpk(dr[2], dr[3]); *(u32x2*)(RHFi + ((ni * 2 + ks_o) * 64 + lane) * 8 + hb) = wv; }
              f32x4 d1;
#pragma unroll
              for (int rg = 0; rg < 4; ++rg) d1[rg] = bf2f(mKH[(k0 + 4 * q + rg) * LDM + n0 + l15]);
              d1 = MFMA16(fH0, fBh0, d1); d1 = MFMA16(fH1, fBh1, d1);
              f32x4 d2 = bkr[nn]; d2 = MFMA16(fH0, fBr0, d2); d2 = MFMA16(fH1, fBr1, d2);
              bkr[nn] = d2; ghH[nn] = d1; }
          BARRIER();
#pragma unroll
          for (int nn = 0; nn < 2; ++nn) { const int n0 = 16 * (nb + nn); st_T(mZ1T, k0, n0, ghH[nn], lane); st_T(mZ2T, k0, n0, bkr[nn], lane); }
        }
        BARRIER();
        { bf16* QFi = QF + (size_t)item * 4096; bf16* OIFi = OIF + (size_t)item * 4096;
#pragma unroll
          for (int nn = 0; nn < 2; ++nn) { const int ni = nb + nn, n0 = 16 * ni;
              f32x4 dq = mm_tile(mZ1T, 16 * mi, mVVT, n0, zero4, lane);
              { u32x2 wv; wv.x = cvtpk(dq[0], dq[1]); wv.y = cvtpk(dq[2], dq[3]); *(u32x2*)(QFi + ((ni * 4 + mi) * 64 + lane) * 4) = wv; }
              f32x4 dov = mm_tile(mVVT, 16 * mi, mZ2T, n0, zero4, lane);
              { u32x2 wv; wv.x = cvtpk(dov[0], dov[1]); wv.y = cvtpk(dov[2], dov[3]); *(u32x2*)(OIFi + ((ni * 4 + mi) * 64 + lane) * 4) = wv; } }
        }
    }
#undef LM
}

__device__ __forceinline__ void pB_scan(Frame& F, unsigned char* ws) {
    const bf16* PF = (const bf16*)(ws + WS_PF); const bf16* QF = (const bf16*)(ws + WS_QF); bf16* SF = (bf16*)(ws + WS_SF);
    const int h = blockIdx.x >> 2, vt = blockIdx.x & 3, lane = F.lane;
    if (F.wave != 0) {
        return;
    }
    f32x4 st[4];
#pragma unroll
    for (int i = 0; i < 4; ++i) st[i] = (f32x4){0.f, 0.f, 0.f, 0.f};
    constexpr int DEPTH = 3;
    bf16x8 pb[DEPTH][8]; u32x2 qb[DEPTH][4];
#pragma unroll
    for (int d = 0; d < DEPTH; ++d) { const size_t it = (size_t)d * 16 + h;
#pragma unroll
        for (int i = 0; i < 8; ++i) pb[d][i] = *(const bf16x8*)(PF + it * 4096 + (i * 64 + lane) * 8);
#pragma unroll
        for (int i = 0; i < 4; ++i) qb[d][i] = *(const u32x2*)(QF + it * 4096 + ((vt * 4 + i) * 64 + lane) * 4); }
    for (int c0 = 0; c0 < 128; c0 += DEPTH) {
#pragma unroll
        for (int d = 0; d < DEPTH; ++d) { const int c = c0 + d;
            if (c < 128) {
                u32x4 b0, b1;
                b0.x = cvtpk(st[0][0], st[0][1]); b0.y = cvtpk(st[0][2], st[0][3]); b0.z = cvtpk(st[1][0], st[1][1]); b0.w = cvtpk(st[1][2], st[1][3]);
                b1.x = cvtpk(st[2][0], st[2][1]); b1.y = cvtpk(st[2][2], st[2][3]); b1.z = cvtpk(st[3][0], st[3][1]); b1.w = cvtpk(st[3][2], st[3][3]);
                const size_t it = (size_t)c * 16 + h;
                *(u32x4*)(SF + it * 4096 + ((vt * 2 + 0) * 64 + lane) * 8) = b0; *(u32x4*)(SF + it * 4096 + ((vt * 2 + 1) * 64 + lane) * 8) = b1;
                const bf16x8 f0 = __builtin_bit_cast(bf16x8, b0), f1 = __builtin_bit_cast(bf16x8, b1);
#pragma unroll
                for (int i = 0; i < 4; ++i) { f32x4 acc = (f32x4){bflo(qb[d][i].x), bfhi(qb[d][i].x), bflo(qb[d][i].y), bfhi(qb[d][i].y)};
                    acc = MFMA16(pb[d][2 * i], f0, acc); acc = MFMA16(pb[d][2 * i + 1], f1, acc); st[i] = acc; }
                const int cn = c + DEPTH;
                if (cn < 128) { const size_t itn = (size_t)cn * 16 + h;
#pragma unroll
                    for (int i = 0; i < 8; ++i) pb[d][i] = *(const bf16x8*)(PF + itn * 4096 + (i * 64 + lane) * 8);
#pragma unroll
                    for (int i = 0; i < 4; ++i) qb[d][i] = *(const u32x2*)(QF + itn * 4096 + ((vt * 4 + i) * 64 + lane) * 4); }
            }
        }
    }
}

__device__ __forceinline__ void pC_out(Frame& F, const Args& a, unsigned char* ws) {
    const bf16* Z = (const bf16*)(ws + WS_Z); bf16* Y = (bf16*)(ws + WS_H);
    const bf16* RHF = (const bf16*)(ws + WS_RHF); const bf16* OIF = (const bf16*)(ws + WS_OIF); const bf16* SF = (const bf16*)(ws + WS_SF);
    const float* BS = (const float*)(ws + WS_BS);
    const float* mu = a.in[4]; const float* lnx_w = a.in[12]; const float* lnx_b = a.in[13];
    const int gw = blockIdx.x * NWAVES + F.wave, NGW = F.G * NWAVES, lane = F.lane, q = lane >> 4, l15 = lane & 15;
    for (int u = gw; u < 8192; u += NGW) {
        const int item = u >> 2, tt = u & 3, c = item >> 4, h = item & 15, t = c * 64 + 16 * tt + l15;
        const bf16x8 r0 = *(const bf16x8*)(RHF + (size_t)item * 4096 + ((tt * 2 + 0) * 64 + lane) * 8), r1 = *(const bf16x8*)(RHF + (size_t)item * 4096 + ((tt * 2 + 1) * 64 + lane) * 8);
        f32x4 o[4]; float sum = 0.f;
#pragma unroll
        for (int vt = 0; vt < 4; ++vt) {
            const bf16x8 s0 = *(const bf16x8*)(SF + (size_t)item * 4096 + ((vt * 2 + 0) * 64 + lane) * 8), s1 = *(const bf16x8*)(SF + (size_t)item * 4096 + ((vt * 2 + 1) * 64 + lane) * 8);
            const u32x2 oi = *(const u32x2*)(OIF + (size_t)item * 4096 + ((tt * 4 + vt) * 64 + lane) * 4);
            f32x4 acc = (f32x4){bflo(oi.x), bfhi(oi.x), bflo(oi.y), bfhi(oi.y)};
            acc = MFMA16(s0, r0, acc); acc = MFMA16(s1, r1, acc);
            o[vt] = acc; sum += (acc[0] + acc[1]) + (acc[2] + acc[3]); }
        sum += __shfl_xor(sum, 16); sum += __shfl_xor(sum, 32);
        const float mean = sum * (1.f / 64.f); float var = 0.f;
#pragma unroll
        for (int vt = 0; vt < 4; ++vt)
#pragma unroll
            for (int rg = 0; rg < 4; ++rg) { const float d = o[vt][rg] - mean; var += d * d; }
        var += __shfl_xor(var, 16); var += __shfl_xor(var, 32);
        const float rstd = 1.0f / sqrtf(var * (1.f / 64.f) + 64e-5f);
        const float bs = BS[(size_t)t * 16 + h];
#pragma unroll
        for (int vt = 0; vt < 4; ++vt) { const int ch = h * 64 + 16 * vt + 4 * q;
            float vv[4], gg[4]; shift4(Z, t, C_V + ch, mu, vv); shift4(Z, t, C_G + ch, mu, gg);
            const f32x4 lw = *(const f32x4*)(lnx_w + ch), lb = *(const f32x4*)(lnx_b + ch);
            float y[4];
#pragma unroll
            for (int rg = 0; rg < 4; ++rg) { const float val = (o[vt][rg] - mean) * rstd * lw[rg] + lb[rg] + bs * vv[rg]; y[rg] = val * gg[rg] / (1.f + __expf(-gg[rg])); }
            u32x2 wv; wv.x = cvtpk(y[0], y[1]); wv.y = cvtpk(y[2], y[3]);
            *(u32x2*)(Y + (size_t)t * DM + ch) = wv; }
    }
}

__global__ void __launch_bounds__(NTHR, 2) fwd_kernel(Args args) {
    extern __shared__ __attribute__((aligned(16))) unsigned char lds[];
    Frame F;
    F.lds = (LAS unsigned char*)lds;
    F.MISC = (volatile LAS unsigned*)(F.lds + MISC_OFF);
    F.tid = threadIdx.x; F.lane = F.tid & 63; F.wave = __builtin_amdgcn_readfirstlane(F.tid >> 6);
    F.G = gridDim.x; { const int bx = blockIdx.x; F.vcu = (F.G % 8 == 0) ? (bx % 8) * (F.G / 8) + bx / 8 : bx; }
    unsigned char* ws = args.ws;
    F.ctl = (gu32*)(ws + WS_CTL);
    for (int u = F.tid; u < (LDS_BYTES - LDSCTL_OFF) / 4; u += NTHR) ((LAS unsigned*)(F.lds + LDSCTL_OFF))[u] = 0u;
    __syncthreads();
#if MK_FUSED
    XcdBarrier bar = xcd_barrier_post((unsigned*)(F.ctl + CW_BAR), F.MISC + 8);
#define GRID_BAR() xcd_barrier(bar)
#else
#define GRID_BAR() do {} while (0)
#endif
    const int lo = args.ph_lo, hi = args.ph_hi;
#define IN(k) (lo <= (k) && (k) < hi)
#define BOTH(k) (IN(k) && IN((k) + 1))
    if (IN(0)) { p0_prologue(F, args, ws); if (BOTH(0)) GRID_BAR(); }
    if (IN(1)) {
        pg8::Gemm g{(const pg8::bf16_t*)(ws + WS_H), (const pg8::bf16_t*)(ws + WS_WTIN), SEQ, NPAD, DM}; pg8::StaticOrder S; S.init(SEQ, NPAD, F.G, (int)blockIdx.x);
        pg8::EpiBf16 E{(pg8::bf16_t*)(ws + WS_Z), ZLD};
        pg8::gemm_phase<pg8::EpiBf16, pg8::StaticOrder, true, true>(F.lds, g, S, E);
        if (BOTH(1)) GRID_BAR();
    }
    if (IN(2)) { p2_attn_prep(F, args, ws); pA_chunk(F, args, ws); if (BOTH(2)) GRID_BAR(); }
    if (IN(3)) {
        if (blockIdx.x < 64) pB_scan(F, ws); else p3_attn(F, args, ws, (int)blockIdx.x - 64, F.G - 64);
        if (BOTH(3)) GRID_BAR();
    }
    if (IN(4)) { pC_out(F, args, ws); if (BOTH(4)) GRID_BAR(); }
    if (IN(5)) {
        pg8::Gemm g{(const pg8::bf16_t*)(ws + WS_H), (const pg8::bf16_t*)(ws + WS_WTOUT), SEQ, DM, DM}; pg8::StaticOrder S; S.init(SEQ, DM, F.G, (int)blockIdx.x);
        pg8::EpiResF32 E{args.in[0], args.out, DM};
        pg8::gemm_phase<pg8::EpiResF32, pg8::StaticOrder, true, true>(F.lds, g, S, E);
    }
#undef IN
#undef BOTH
}

extern "C" void kernel_launch(void* const* d_in, const int* in_sizes, int n_in, void* d_out, int out_size, void* d_ws, size_t ws_size, hipStream_t stream) {
    static int grid = 0;
    if (grid == 0) {
        if (n_in != 18 || in_sizes[0] != SEQ * DM || out_size != SEQ * DM || ws_size < WS_END) { fprintf(stderr, "kernel_launch: unexpected shapes (n_in %d, in0 %d, out %d, ws %zu)\n", n_in, n_in > 0 ? in_sizes[0] : -1, out_size, ws_size); grid = -1; return; }
        int dev = 0, cus = 0;
        if (hipGetDevice(&dev) != hipSuccess || hipDeviceGetAttribute(&cus, hipDeviceAttributeMultiprocessorCount, dev) != hipSuccess) { grid = -1; return; }
        if (hipFuncSetAttribute((const void*)fwd_kernel, hipFuncAttributeMaxDynamicSharedMemorySize, LDS_BYTES) != hipSuccess) { fprintf(stderr, "kernel_launch: hipFuncSetAttribute failed\n"); grid = -1; return; }
        (void)hipGetLastError();
        grid = cus;
        if (grid != 256) fprintf(stderr, "kernel_launch: %d CUs (built for 256)\n", grid);
    }
    if (grid < 0) return;
    (void)hipMemsetAsync((char*)d_ws + WS_CTL, 0, CTL_ZERO_BYTES, stream);
    Args a{};
    for (int i = 0; i < 18; ++i) a.in[i] = (const float*)d_in[i];
    a.out = (float*)d_out; a.ws = (unsigned char*)d_ws;
#if MK_FUSED
    a.ph_lo = 0; a.ph_hi = N_PHASES;
    hipLaunchKernelGGL(fwd_kernel, dim3(grid), dim3(NTHR), LDS_BYTES, stream, a);
#else
    for (int p = 0; p < N_PHASES; ++p) { a.ph_lo = p; a.ph_hi = p + 1; hipLaunchKernelGGL(fwd_kernel, dim3(grid), dim3(NTHR), LDS_BYTES, stream, a); }
#endif
}
```

```cpp
#include <hip/hip_runtime.h>
#include <cstdio>
#include <cstdint>
namespace pg8 {
#define PG8_LAS __attribute__((address_space(3)))
typedef unsigned short bf16_t;
typedef short bf16x8 __attribute__((ext_vector_type(8)));
typedef float f32x4 __attribute__((ext_vector_type(4)));
typedef unsigned u32x4 __attribute__((ext_vector_type(4)));
constexpr int BM = 256, BK = 64, HALF = 128, HTB = HALF * BK * 2  , STAGE_BYTES = 8 * HTB, NXCD = 8, WGM = 8;

__host__ __device__ __forceinline__ int lds_byte(int r, int c) { const int st = (r >> 4) * 2 + (c >> 5), rr = r & 15, cc = c & 31, ob = rr * 64 + cc * 2; return st * 1024 + (ob ^ (((ob >> 9) & 1) << 5)); }
__host__ __device__ __forceinline__ void stage_rc(int b, int& R, int& C) { const int st = b / 1024, sb = b % 1024, swz = sb ^ (((sb >> 9) & 1) << 5); R = (st >> 1) * 16 + swz / 64; C = (st & 1) * 32 + (swz % 64) / 2; }
__host__ __device__ __forceinline__ int perm32(int rho) { const int n = rho >> 4, i = rho & 15; return 8 * (i >> 2) + 4 * n + (i & 3); }

struct Unit { int pm, pn; };
struct Gemm { const bf16_t* A; const bf16_t* Bt; int M, N, K; };

struct StaticOrder {
    int nM, nN, nwg, G, c;
    __host__ __device__ void init(int M, int N, int G_, int c_) { nM = M / BM; nN = N / BM; nwg = nM * nN; G = G_; c = c_; }
    __host__ __device__ bool next(int i, Unit& u) const {
        const long L = (long)i * G + c; if (L >= nwg) return false;
        int wgid = (int)L; { const int q = nwg / NXCD, r = nwg % NXCD, xcd = wgid % NXCD, off = wgid / NXCD; wgid = (xcd < r ? xcd * (q + 1) : r * (q + 1) + (xcd - r) * q) + off; }
        const int nig = WGM * nN, gid = wgid / nig, fm = gid * WGM, gsz = (nM - fm) < WGM ? (nM - fm) : WGM;
        u.pm = fm + ((wgid % nig) % gsz); u.pn = (wgid % nig) / gsz; return true;
    }
    __device__ __forceinline__ void a_ready(const Unit&) const {}
    __device__ __forceinline__ void done(const Unit&) const {}
};

__device__ __forceinline__ unsigned cvt_pk_bf16(float lo, float hi) { unsigned r; asm volatile("v_cvt_pk_bf16_f32 %0, %1, %2" : "=v"(r) : "v"(lo), "v"(hi)); return r; }
typedef float f32x2 __attribute__((ext_vector_type(2)));

struct EpiBf16 {
    static constexpr bool PERM = true, AFTER_DRAIN = false;
    bf16_t* O; int ldc; bf16_t* VT;
    __device__ __forceinline__ void operator()(const f32x4 (&acc)[2][2][4][2], const Unit& u, int wr, int wc, int fr, int fq) const {
        const int row0 = u.pm * BM + wr * 64 + fr; const int col0 = u.pn * BM + wc * 32 + 8 * fq;
#pragma unroll
        for (int ai = 0; ai < 2; ++ai)
#pragma unroll
            for (int m = 0; m < 4; ++m) { bf16_t* rowp = O + (size_t)(row0 + ai * HALF + m * 16) * ldc + col0;
#pragma unroll
                for (int bj = 0; bj < 2; ++bj) { const f32x4 v0 = acc[ai][bj][m][0], v1 = acc[ai][bj][m][1];
                    u32x4 w; w.x = cvt_pk_bf16(v0[0], v0[1]); w.y = cvt_pk_bf16(v0[2], v0[3]); w.z = cvt_pk_bf16(v1[0], v1[1]); w.w = cvt_pk_bf16(v1[2], v1[3]);
                    *(u32x4*)(rowp + bj * HALF) = w; } }
        if (u.pn == 21) {
            const int d0 = wc * 32 + 8 * fq;
#pragma unroll
            for (int ai = 0; ai < 2; ++ai)
#pragma unroll
                for (int m = 0; m < 4; ++m) { const int row = row0 + ai * HALF + m * 16; const f32x4 v0 = acc[ai][0][m][0], v1 = acc[ai][0][m][1];
                    const unsigned w0 = cvt_pk_bf16(v0[0], v0[1]), w1 = cvt_pk_bf16(v0[2], v0[3]), w2 = cvt_pk_bf16(v1[0], v1[1]), w3 = cvt_pk_bf16(v1[2], v1[3]);
                    bf16_t* p = VT + (size_t)d0 * 8192 + row;
                    p[0] = (bf16_t)(w0 & 0xffffu); p[8192] = (bf16_t)(w0 >> 16); p[2 * 8192] = (bf16_t)(w1 & 0xffffu); p[3 * 8192] = (bf16_t)(w1 >> 16);
                    p[4 * 8192] = (bf16_t)(w2 & 0xffffu); p[5 * 8192] = (bf16_t)(w2 >> 16); p[6 * 8192] = (bf16_t)(w3 & 0xffffu); p[7 * 8192] = (bf16_t)(w3 >> 16); }
        }
    }
};
struct EpiResF32 {
    static constexpr bool PERM = false, AFTER_DRAIN = false;
    const float* base; float* out; int ldc;
    __device__ __forceinline__ void operator()(const f32x4 (&acc)[2][2][4][2], const Unit& u, int wr, int wc, int fr, int fq) const {
        const int row0 = u.pm * BM + wr * 64 + fr; const int col0 = u.pn * BM + wc * 32 + 4 * fq;
#pragma unroll
        for (int ai = 0; ai < 2; ++ai)
#pragma unroll
            for (int m = 0; m < 4; ++m) { const size_t off = (size_t)(row0 + ai * HALF + m * 16) * ldc + col0;
#pragma unroll
                for (int bj = 0; bj < 2; ++bj)
#pragma unroll
                    for (int n = 0; n < 2; ++n) { const f32x4 bs = *(const f32x4*)(base + off + bj * HALF + n * 16); *(f32x4*)(out + off + bj * HALF + n * 16) = bs + acc[ai][bj][m][n]; } }
    }
};
template <class Epi, class Sched, bool ALIGN_EPI = false, bool SP2 = false>
__device__ __forceinline__ void gemm_phase(PG8_LAS unsigned char* lds, const Gemm g, const Sched& S, const Epi& E) {
    const int tid = threadIdx.x, wid = __builtin_amdgcn_readfirstlane(tid >> 6), lane = tid & 63, wr = wid >> 2, wc = wid & 3, fr = lane & 15, fq = lane >> 4;
    const int K = g.K, nt = K / BK;
    unsigned voffA[2], voffB[2];
#pragma unroll
    for (int i = 0; i < 2; ++i) { int R, C; stage_rc(tid * 16 + i * 8192, R, C); const int Rb = Epi::PERM ? ((R & ~31) + perm32(R & 31)) : R;
        voffA[i] = (unsigned)(R * K + C) * 2u; voffB[i] = (unsigned)(Rb * K + C) * 2u; }
    const size_t kstep = (size_t)(BK * 2);
    const size_t hstep = (size_t)HALF * K * 2;
    const size_t tstep = 2 * hstep;
    const unsigned ldsw = (unsigned)wid * 1024u;
    const int aoff = lds_byte(wr * 64 + fr, fq * 8), boff = lds_byte(wc * 32 + fr, fq * 8);
#define PG8_SA(b, h) (((b) * 2 + (h)) * HTB)
#define PG8_SB(b, h) ((4 + (b) * 2 + (h)) * HTB)
#define PG8_STAGE(bufoff, gbase, voff) do { _Pragma("unroll") for (int _i = 0; _i < 2; ++_i) \
        __builtin_amdgcn_global_load_lds((const unsigned*)((const char*)(gbase) + (voff)[_i]), (PG8_LAS unsigned*)(lds + (bufoff) + ldsw + _i * 8192), 16, 0, 0); } while (0)
#define PG8_LDA(dst, b, h) do { _Pragma("unroll") for (int m = 0; m < 4; ++m) _Pragma("unroll") for (int k = 0; k < 2; ++k) dst[m][k] = *(const PG8_LAS bf16x8*)(lds + PG8_SA(b, h) + aoff + m * 2048 + k * 1024); } while (0)
#define PG8_LDB(dst, b, h) do { _Pragma("unroll") for (int n = 0; n < 2; ++n) _Pragma("unroll") for (int k = 0; k < 2; ++k) dst[n][k] = *(const PG8_LAS bf16x8*)(lds + PG8_SB(b, h) + boff + n * 2048 + k * 1024); } while (0)
#define PG8_MMA(ai, bj, At, Bt) do { __builtin_amdgcn_s_setprio(1); _Pragma("unroll") for (int m = 0; m < 4; ++m) _Pragma("unroll") for (int n = 0; n < 2; ++n) _Pragma("unroll") for (int k = 0; k < 2; ++k) \
        acc[ai][bj][m][n] = __builtin_amdgcn_mfma_f32_16x16x32_bf16(Bt[n][k], At[m][k], acc[ai][bj][m][n], 0, 0, 0); __builtin_amdgcn_s_setprio(0); } while (0)
#define PG8_WAIT_V(n) asm volatile("s_waitcnt vmcnt(" #n ")" ::: "memory")
#define PG8_WAIT_L(n) asm volatile("s_waitcnt lgkmcnt(" #n ")" ::: "memory")
#define PG8_BAR __builtin_amdgcn_s_barrier()
#define PG8_SCHED __builtin_amdgcn_sched_barrier(0)
    Unit cur, nxt; int ui = 0;
    if (!S.next(0, cur)) return;
    f32x4 acc[2][2][4][2];
#pragma unroll
    for (int a = 0; a < 2; ++a)
#pragma unroll
        for (int b = 0; b < 2; ++b)
#pragma unroll
            for (int m = 0; m < 4; ++m)
#pragma unroll
                for (int n = 0; n < 2; ++n) acc[a][b][m][n] = (f32x4){0.f, 0.f, 0.f, 0.f};
    bf16x8 At[4][2], B0[2][2], B1[2][2];
    const char* cA = (const char*)g.A + (size_t)cur.pm * tstep; const char* cB = (const char*)g.Bt + (size_t)cur.pn * tstep;
    S.a_ready(cur);
    if constexpr (SP2) {
        PG8_STAGE(PG8_SB(0, 0), cB, voffB); PG8_STAGE(PG8_SB(0, 1), cB + hstep, voffB); PG8_STAGE(PG8_SA(0, 0), cA, voffA); PG8_STAGE(PG8_SA(0, 1), cA + hstep, voffA);
        if (wr == 1) PG8_BAR;
        PG8_WAIT_V(2); PG8_BAR;
        PG8_STAGE(PG8_SB(1, 0), cB + kstep, voffB); PG8_STAGE(PG8_SA(1, 0), cA + kstep, voffA); PG8_STAGE(PG8_SB(1, 1), cB + hstep + kstep, voffB);
        PG8_WAIT_V(6); PG8_BAR;
    } else {
        PG8_STAGE(PG8_SB(0, 0), cB, voffB); PG8_STAGE(PG8_SA(0, 0), cA, voffA); PG8_STAGE(PG8_SB(0, 1), cB + hstep, voffB); PG8_STAGE(PG8_SA(0, 1), cA + hstep, voffA);
        if (wr == 1) PG8_BAR;
        PG8_WAIT_V(4); PG8_BAR;
        PG8_STAGE(PG8_SB(1, 0), cB + kstep, voffB); PG8_STAGE(PG8_SA(1, 0), cA + kstep, voffA); PG8_STAGE(PG8_SB(1, 1), cB + hstep + kstep, voffB);
        PG8_WAIT_V(6); PG8_BAR;
    }
    for (;;) {
        const bool has_next = S.next(ui + 1, nxt);
        const char* nA = has_next ? (const char*)g.A + (size_t)nxt.pm * tstep : cA; const char* nB = has_next ? (const char*)g.Bt + (size_t)nxt.pn * tstep : cB;
        for (int t = 0; t < nt; t += 2) {
            const bool last = (t == nt - 2);
            const char* a1 = cA + (size_t)(t + 1) * kstep;
            const char* a2 = last ? nA : cA + (size_t)(t + 2) * kstep; const char* b2 = last ? nB : cB + (size_t)(t + 2) * kstep;
            const char* a3 = a2 + kstep; const char* b3 = b2 + kstep;
            if (last && has_next) S.a_ready(nxt);
            if constexpr (SP2) {
            PG8_LDB(B0, 0, 0); PG8_LDB(B1, 0, 1); PG8_SCHED; PG8_LDA(At, 0, 0); PG8_STAGE(PG8_SA(1, 1), a1 + hstep, voffA);
            PG8_WAIT_V(8); PG8_WAIT_L(0); PG8_BAR; PG8_MMA(0, 0, At, B0); PG8_MMA(0, 1, At, B1); PG8_BAR; PG8_SCHED;
            PG8_LDA(At, 0, 1); PG8_STAGE(PG8_SB(0, 0), b2, voffB); PG8_STAGE(PG8_SB(0, 1), b2 + hstep, voffB); PG8_STAGE(PG8_SA(0, 0), a2, voffA);
            PG8_WAIT_V(8); PG8_WAIT_L(0); PG8_BAR; PG8_MMA(1, 0, At, B0); PG8_MMA(1, 1, At, B1); PG8_BAR; PG8_SCHED;
            PG8_LDB(B0, 1, 0); PG8_LDB(B1, 1, 1); PG8_SCHED; PG8_LDA(At, 1, 0); PG8_STAGE(PG8_SA(0, 1), a2 + hstep, voffA);
            PG8_WAIT_V(8); PG8_WAIT_L(0); PG8_BAR; PG8_MMA(0, 0, At, B0); PG8_MMA(0, 1, At, B1); PG8_BAR; PG8_SCHED;
            PG8_LDA(At, 1, 1); PG8_STAGE(PG8_SB(1, 0), b3, voffB); PG8_STAGE(PG8_SB(1, 1), b3 + hstep, voffB); PG8_STAGE(PG8_SA(1, 0), a3, voffA);
            PG8_WAIT_V(8); PG8_WAIT_L(0); PG8_BAR; PG8_MMA(1, 0, At, B0); PG8_MMA(1, 1, At, B1); PG8_BAR; PG8_SCHED;
            } else {
            PG8_LDB(B0, 0, 0); PG8_SCHED; PG8_LDA(At, 0, 0); PG8_STAGE(PG8_SA(1, 1), a1 + hstep, voffA);
            PG8_WAIT_L(8); PG8_BAR; PG8_WAIT_L(0); PG8_MMA(0, 0, At, B0); PG8_BAR; PG8_SCHED;
            PG8_LDB(B1, 0, 1); PG8_STAGE(PG8_SB(0, 0), b2, voffB);
            PG8_BAR; PG8_WAIT_L(0); PG8_MMA(0, 1, At, B1); PG8_BAR;
            PG8_LDA(At, 0, 1); PG8_STAGE(PG8_SA(0, 0), a2, voffA);
            PG8_BAR; PG8_WAIT_L(0); PG8_MMA(1, 0, At, B0); PG8_BAR; PG8_SCHED;
            PG8_STAGE(PG8_SB(0, 1), b2 + hstep, voffB);
            PG8_WAIT_V(6); PG8_BAR; PG8_MMA(1, 1, At, B1); PG8_BAR;
            PG8_LDB(B0, 1, 0); PG8_SCHED; PG8_LDA(At, 1, 0); PG8_STAGE(PG8_SA(0, 1), a2 + hstep, voffA);
            PG8_WAIT_L(8); PG8_BAR; PG8_WAIT_L(0); PG8_MMA(0, 0, At, B0); PG8_BAR; PG8_SCHED;
            PG8_LDB(B1, 1, 1); PG8_STAGE(PG8_SB(1, 0), b3, voffB);
            PG8_BAR; PG8_WAIT_L(0); PG8_MMA(0, 1, At, B1); PG8_BAR;
            PG8_LDA(At, 1, 1); PG8_STAGE(PG8_SA(1, 0), a3, voffA);
            PG8_BAR; PG8_WAIT_L(0); PG8_MMA(1, 0, At, B0); PG8_BAR; PG8_SCHED;
            PG8_STAGE(PG8_SB(1, 1), b3 + hstep, voffB);
            PG8_WAIT_V(6); PG8_BAR; PG8_MMA(1, 1, At, B1); PG8_BAR;
            }
        }
        if constexpr (ALIGN_EPI) { if (wr == 0) PG8_BAR; }
        if constexpr (!Epi::AFTER_DRAIN) { E(acc, cur, wr, wc, fr, fq); S.done(cur); }
        if (!has_next) break;
#pragma unroll
        for (int a = 0; a < 2; ++a)
#pragma unroll
            for (int b = 0; b < 2; ++b)
#pragma unroll
                for (int m = 0; m < 4; ++m)
#pragma unroll
                    for (int n = 0; n < 2; ++n) acc[a][b][m][n] = (f32x4){0.f, 0.f, 0.f, 0.f};
        cur = nxt; cA = nA; cB = nB; ++ui;
        if constexpr (ALIGN_EPI) { if (wr == 1) PG8_BAR; }
    }
    PG8_WAIT_V(0);
    if constexpr (!ALIGN_EPI) { if (wr == 0) PG8_BAR; }
    PG8_BAR;
    if constexpr (Epi::AFTER_DRAIN) { E.fused(acc, cur, wr, wc, fr, fq, lds, wid, lane); S.done(cur); }
#undef PG8_SA
#undef PG8_SB
#undef PG8_STAGE
#undef PG8_LDA
#undef PG8_LDB
#undef PG8_MMA
#undef PG8_WAIT_V
#undef PG8_WAIT_L
#undef PG8_BAR
#undef PG8_SCHED
}
}

#define GAS __attribute__((address_space(1)))
#define LAS __attribute__((address_space(3)))
typedef unsigned short bf16;
typedef unsigned v4u __attribute__((ext_vector_type(4)));
typedef float f32x4 __attribute__((ext_vector_type(4)));
typedef short bf16x8 __attribute__((ext_vector_type(8)));
typedef GAS unsigned gu32;
typedef GAS unsigned long long gu64;
#define RLX_AGENT __ATOMIC_RELAXED, __HIP_MEMORY_SCOPE_AGENT
#define LDS_WAIT() asm volatile("s_waitcnt lgkmcnt(0)" ::: "memory")
#define VM_WAIT() asm volatile("s_waitcnt vmcnt(0)" ::: "memory")
__device__ __forceinline__ unsigned long long rt() { return __builtin_amdgcn_s_memrealtime(); }
__device__ __forceinline__ unsigned f2bf(float f) { unsigned u = __builtin_bit_cast(unsigned, f); return (u + 0x7fffu + ((u >> 16) & 1u)) >> 16; }
__device__ __forceinline__ unsigned pk2(float lo, float hi) { return f2bf(lo) | (f2bf(hi) << 16); }


#define XB_TMO      128
#define XB_XCNT(j)  (256  + 64 * (j))
#define XB_XSUB(j)  (1280 + 64 * (j))
#define XB_XGEN(j)  (2304 + 64 * (j))
#define XB_TOP      3328
#define XB_TOPGEN   3392
#define XCD_BAR_WORDS 3456
#define XB_SPIN_CAP (1u << 18)

__device__ __forceinline__ unsigned xb_ld(unsigned* p)              { return __hip_atomic_load(p, __ATOMIC_RELAXED, __HIP_MEMORY_SCOPE_AGENT); }
__device__ __forceinline__ unsigned xb_add(unsigned* p, unsigned v) { return __hip_atomic_fetch_add(p, v, __ATOMIC_RELAXED, __HIP_MEMORY_SCOPE_AGENT); }
__device__ __forceinline__ unsigned xb_xcc_id() { return (unsigned)__builtin_amdgcn_s_getreg((3 << 11) | 20) & 0xFu; }
#define XB_SPIN(cond, bar) do { unsigned _sp = 0; while (cond) { __builtin_amdgcn_s_sleep(1); \
    if ((++_sp & 255u) == 0u) { if (xb_ld(&(bar)[XB_TMO])) break; if (_sp > XB_SPIN_CAP) { atomicAdd(&(bar)[XB_TMO], 1u); break; } } } } while (0)

struct XcdBarrier {
    unsigned* bar; unsigned x;
    volatile LAS unsigned* st;
};

__device__ __forceinline__ XcdBarrier xcd_barrier_post(unsigned* bar, volatile LAS unsigned* st) {
    XcdBarrier b; b.bar = bar; b.x = xb_xcc_id(); b.st = st;
    if (threadIdx.x == 0) (void)xb_add(&bar[XB_XCNT(b.x)], 1u);
    return b;
}
__device__ __forceinline__ void xcd_barrier_complete(unsigned* bar, unsigned x, unsigned& nloc, unsigned& nx) {
    const unsigned G = gridDim.x * gridDim.y * gridDim.z;
    unsigned sum, cnt, mine, sp = 0u;
    for (;;) {
        sum = 0u; cnt = 0u; mine = 0u;
#pragma unroll
        for (unsigned j = 0; j < 16; ++j) { const unsigned c = xb_ld(&bar[XB_XCNT(j)]); sum += c; cnt += (c > 0u) ? 1u : 0u; mine = (j == x) ? c : mine; }
        if (sum == G) break;
        __builtin_amdgcn_s_sleep(1);
        if ((++sp & 255u) == 0u) { if (xb_ld(&bar[XB_TMO])) break; if (sp > XB_SPIN_CAP) { atomicAdd(&bar[XB_TMO], 1u); break; } }
    }
    nloc = mine > 0u ? mine : 1u; nx = cnt > 0u ? cnt : 1u;
}

__device__ __forceinline__ void xcd_barrier(const XcdBarrier& b) {
    asm volatile("s_waitcnt vmcnt(0)" ::: "memory");
    __syncthreads();
    if (threadIdx.x == 0) {
        unsigned* bar = b.bar;
        __builtin_amdgcn_s_waitcnt(0);
        unsigned nloc = b.st[0], nx = b.st[1];
        if (nloc == 0u) { xcd_barrier_complete(bar, b.x, nloc, nx); b.st[0] = nloc; b.st[1] = nx; }
        const unsigned old = xb_add(&bar[XB_XSUB(b.x)], 1u);
        const unsigned gen = old / nloc;
        if (old + 1u == (gen + 1u) * nloc) {
            __builtin_amdgcn_fence(__ATOMIC_RELEASE, "agent");
            asm volatile("s_waitcnt vmcnt(0)" ::: "memory");
            const unsigned og = xb_add(&bar[XB_TOP], 1u);
            const unsigned tg = og / nx;
            if (og + 1u == (tg + 1u) * nx) xb_add(&bar[XB_TOPGEN], 1u);
            else XB_SPIN(xb_ld(&bar[XB_TOPGEN]) == tg, bar);
            __builtin_amdgcn_fence(__ATOMIC_ACQUIRE, "agent");
            xb_add(&bar[XB_XGEN(b.x)], 1u);
            asm volatile("s_waitcnt vmcnt(0)" ::: "memory");
        } else {
            XB_SPIN(xb_ld(&bar[XB_XGEN(b.x)]) == gen, bar);
            __builtin_amdgcn_fence(__ATOMIC_ACQUIRE, "agent");
            asm volatile("s_waitcnt vmcnt(0)" ::: "memory");
        }
    }
    __syncthreads();
}

constexpr int NWAVES = 8, NTHR = 512;
constexpr int SEQ = 8192, DM = 2048, DIN = 6528, NPAD = 6656, ZLD = 6656;
constexpr int C_R = 0, C_K = 1024, C_V = 2048, C_G = 3072, C_WL = 4096, C_AL = 4160, C_Q = 4224, C_AK = 5248, C_AV = 5376, C_AG = 5504;
constexpr int NH = 16, HD = 64, DR = 1024;
#ifndef MK_FUSED
#define MK_FUSED 1
#endif
constexpr int N_PHASES = 6;
#ifndef PROBE_DUP
#define PROBE_DUP -1
#endif
#ifndef PROBE_SEQ
#define PROBE_SEQ 0
#endif
#define REP(k) _Pragma("unroll 1") for (int rep_ = 0; rep_ < ((PROBE_DUP == (k)) ? 1 + (args.ph_lo == 0) : 1); ++rep_)
constexpr size_t MiB = 1u << 20;
constexpr size_t WS_CTL = 0, CTL_ZERO_BYTES = 1 * MiB;
constexpr size_t WS_WTOUT = 1 * MiB;
constexpr size_t WS_Z = 9 * MiB;
constexpr size_t WS_H = 113 * MiB;
constexpr size_t WS_WTIN = 145 * MiB;
constexpr size_t WS_PF = 145 * MiB, WS_QF = 161 * MiB, WS_RHF = 177 * MiB, WS_OIF = 193 * MiB, WS_SF = 209 * MiB;
constexpr size_t WS_VT = 225 * MiB;
constexpr size_t WS_BS = 227 * MiB;
constexpr size_t WS_W2T = 240 * MiB, WS_A2T = 241 * MiB;
constexpr size_t WS_END = 256 * MiB;
constexpr int CW_BAR = 4096;
constexpr int RING_BYTES = 131072, LDSCTL_OFF = RING_BYTES, MISC_OFF = LDSCTL_OFF + 320, LDS_BYTES = 147456;

struct Frame {
    LAS unsigned char* lds;
    volatile LAS unsigned* MISC;
    gu32* ctl;
    int tid, lane, wave, vcu, G;
};
struct Args { const float* in[18]; float* out; unsigned char* ws; int ph_lo, ph_hi; };

__device__ __forceinline__ float wave_sum(float v) {
#pragma unroll
    for (int o = 1; o < 64; o <<= 1) v += __shfl_xor(v, o);
    return v;
}
__device__ __forceinline__ float bf2f(bf16 b) { return __builtin_bit_cast(float, (unsigned)b << 16); }
__device__ __forceinline__ float bflo(unsigned w) { return __builtin_bit_cast(float, w << 16); }
__device__ __forceinline__ float bfhi(unsigned w) { return __builtin_bit_cast(float, w & 0xffff0000u); }

__device__ __forceinline__ void p0_transpose_item(const float* W, int K, int N, bf16* WT, LAS float* scr, int item, int lane) {
    const int nblk = N / 32, kb = item / nblk, nb = item % nblk, k0 = 64 * kb, n0 = 32 * nb;
#pragma unroll 8
    for (int i = 0; i < 32; ++i) { const int kk = 2 * i + (lane >> 5); scr[kk * 33 + (lane & 31)] = W[(size_t)(k0 + kk) * N + n0 + (lane & 31)]; }
    LDS_WAIT(); asm volatile("" ::: "memory");
    const int c = lane & 7;
#pragma unroll
    for (int j = 0; j < 4; ++j) { const int n = (lane >> 3) + 8 * j; const LAS float* s = scr + (8 * c) * 33 + n;
        v4u o; o.x = pk2(s[0 * 33], s[1 * 33]); o.y = pk2(s[2 * 33], s[3 * 33]); o.z = pk2(s[4 * 33], s[5 * 33]); o.w = pk2(s[6 * 33], s[7 * 33]);
        *(GAS v4u*)(WT + (size_t)(n0 + n) * K + k0 + 8 * c) = o; }
    LDS_WAIT(); asm volatile("" ::: "memory");
}

__device__ __forceinline__ void p0_prologue(Frame& F, const Args& a, unsigned char* ws) {
    const float* x = a.in[0]; const float* norm_w = a.in[1]; const float* w_in = a.in[2]; const float* w_out = a.in[3];
    bf16* WTIN = (bf16*)(ws + WS_WTIN); bf16* WTOUT = (bf16*)(ws + WS_WTOUT); bf16* H = (bf16*)(ws + WS_H);
    LAS float* scr = (LAS float*)(F.lds + F.wave * 16384);
    const int gw = F.vcu * NWAVES + F.wave, NGW = F.G * NWAVES;
    constexpr int I_IN = (DM / 64) * (DIN / 32), I_OUT = (DM / 64) * (DM / 32);
    for (int it = gw; it < I_IN + I_OUT; it += NGW) {
        if (it < I_IN) p0_transpose_item(w_in, DM, DIN, WTIN, scr, it, F.lane);
        else p0_transpose_item(w_out, DM, DM, WTOUT, scr, it - I_IN, F.lane);
    }
    { GAS v4u* p = (GAS v4u*)(WTIN + (size_t)DIN * DM); const int n16 = (NPAD - DIN) * DM * 2 / 16;
      for (int i = blockIdx.x * NTHR + F.tid; i < n16; i += F.G * NTHR) p[i] = (v4u){0u, 0u, 0u, 0u}; }
    { bf16* W2T = (bf16*)(ws + WS_W2T); bf16* A2T = (bf16*)(ws + WS_A2T); const float* w2 = a.in[6]; const float* a2 = a.in[8];
      for (int i = blockIdx.x * NTHR + F.tid; i < 16 * 64 * 64; i += F.G * NTHR) { const int j = i & 63, hk = i >> 6;
          W2T[i] = (bf16)f2bf(w2[j * DR + hk]); A2T[i] = (bf16)f2bf(a2[j * DR + hk]); } }
    for (int m = gw; m < SEQ; m += NGW) {
        const GAS f32x4* xr = (const GAS f32x4*)(x + (size_t)m * DM) + F.lane;
        f32x4 v[8]; float s = 0.f;
#pragma unroll
        for (int j = 0; j < 8; ++j) { v[j] = xr[64 * j]; s += (v[j].x * v[j].x + v[j].y * v[j].y) + (v[j].z * v[j].z + v[j].w * v[j].w); }
        const float rstd = 1.0f / sqrtf(wave_sum(s) * (1.f / DM) + 1e-6f);
        GAS unsigned long long* o8 = (GAS unsigned long long*)(H + (size_t)m * DM) + F.lane;
        const GAS f32x4* nw = (const GAS f32x4*)norm_w + F.lane;
#pragma unroll
        for (int j = 0; j < 8; ++j) { const f32x4 g = nw[64 * j];
            o8[64 * j] = (unsigned long long)pk2(v[j].x * rstd * g.x, v[j].y * rstd * g.y) | ((unsigned long long)pk2(v[j].z * rstd * g.z, v[j].w * rstd * g.w) << 32); }
    }
}

typedef float f32x16 __attribute__((ext_vector_type(16)));
typedef unsigned u32x4 __attribute__((ext_vector_type(4)));
typedef unsigned u32x2 __attribute__((ext_vector_type(2)));
typedef __bf16 bf16x2v __attribute__((ext_vector_type(2))); typedef float f32x2v __attribute__((ext_vector_type(2)));
__device__ __forceinline__ unsigned cvtpk2(float lo, float hi) { f32x2v v = {lo, hi}; bf16x2v b = __builtin_convertvector(v, bf16x2v); return __builtin_bit_cast(unsigned, b); }
constexpr int AT_LDK = 72, AT_LDV = 260;
constexpr int AT_OFF_TB = 0, AT_OFF_K = 12288, AT_OFF_V = AT_OFF_K + 256 * AT_LDK * 2;
__device__ __forceinline__ void p3_attn(Frame& F, const Args& a, unsigned char* ws, int ablk, int nablk) {
    const bf16* Z = (const bf16*)(ws + WS_Z); const bf16* VT = (const bf16*)(ws + WS_VT); bf16* Y = (bf16*)(ws + WS_H);
    const float* qnw = a.in[14]; const float* knw = a.in[15]; const float* sinks = a.in[16]; const float* rel_bias = a.in[17];
    LAS float* tb = (LAS float*)(F.lds + AT_OFF_TB);
    LAS bf16* Kl = (LAS bf16*)(F.lds + AT_OFF_K); LAS bf16* Vl = (LAS bf16*)(F.lds + AT_OFF_V);
    for (int i = F.tid; i < 16 * 192; i += NTHR) { const int h = i / 192, d = i % 192 - 32;
        float v = -INFINITY;
        if (d >= 0 && d < 128) { int b; if (d < 16) b = d; else { b = 16 + (int)(logf((float)d * (1.f / 16.f)) / logf(8.f) * 16.f); if (b > 31) b = 31; }
            v = rel_bias[b * 16 + h] * 1.4426950408889634f; }
        tb[i] = v; }
    const int tid = F.tid, lane = F.lane, r = lane & 31, h = lane >> 5, w = F.wave;
    for (int unit = ablk; unit < 128; unit += nablk) {
        const int nb = unit >> 1, hk = unit & 1, kw0 = nb * 128 - 128;
        __syncthreads();
#pragma unroll
        for (int i = 0; i < 4; ++i) { const int p = tid + NTHR * i, key = p >> 3, oct = p & 7; int t = kw0 + key; if (t < 0) t = 0;
            const v4u kv = *(const v4u*)(Z + (size_t)t * ZLD + C_AK + hk * 64 + 8 * oct);
            float f[8] = {bflo(kv.x), bfhi(kv.x), bflo(kv.y), bfhi(kv.y), bflo(kv.z), bfhi(kv.z), bflo(kv.w), bfhi(kv.w)};
            float ss = 0.f;
#pragma unroll
            for (int e = 0; e < 8; ++e) ss += f[e] * f[e];
            ss += __shfl_xor(ss, 1); ss += __shfl_xor(ss, 2); ss += __shfl_xor(ss, 4);
            const float rstd = 1.0f / sqrtf(ss * (1.f / 64.f) + 1e-6f);
            const f32x4 g0 = *(const f32x4*)(knw + 8 * oct), g1 = *(const f32x4*)(knw + 8 * oct + 4);
            v4u o; o.x = cvtpk2(f[0] * rstd * g0.x, f[1] * rstd * g0.y); o.y = cvtpk2(f[2] * rstd * g0.z, f[3] * rstd * g0.w);
            o.z = cvtpk2(f[4] * rstd * g1.x, f[5] * rstd * g1.y); o.w = cvtpk2(f[6] * rstd * g1.z, f[7] * rstd * g1.w);
            *(LAS v4u*)(Kl + key * AT_LDK + 8 * oct) = o; }
#pragma unroll
        for (int i = 0; i < 4; ++i) { const int p = tid + NTHR * i, d = p >> 5, kc = p & 31; int t = kw0 + 8 * kc; if (t < 0) t = 0;
            const v4u vv = *(const v4u*)(VT + (size_t)(hk * 64 + d) * SEQ + t);
            LAS u32x2* dst = (LAS u32x2*)(Vl + d * AT_LDV + 8 * kc); dst[0] = (u32x2){vv.x, vv.y}; dst[1] = (u32x2){vv.z, vv.w}; }
        __syncthreads();
        const int hq = hk * 8 + w;
        const LAS float* tbl = tb + hq * 192 + (160 + r - 4 * h);
        const float sink = sinks[hq] * 1.4426950408889634f;
        v4u qraw[4];
#pragma unroll
        for (int s = 0; s < 4; ++s) qraw[s] = *(const v4u*)(Z + (size_t)(nb * 128 + r) * ZLD + C_Q + hq * 64 + 16 * s + 8 * h);
        for (int slab = 0; slab < 4; ++slab) {
            const int q0 = nb * 128 + slab * 32;
            u32x2 gwv[8];
#pragma unroll
            for (int i = 0; i < 8; ++i) gwv[i] = *(const u32x2*)(Z + (size_t)(q0 + r) * ZLD + C_AG + hq * 64 + 32 * (i >> 2) + 8 * (i & 3) + 4 * h);
            v4u qnext[4];
            { const int qn = (slab < 3) ? q0 + 32 : q0;
#pragma unroll
              for (int s = 0; s < 4; ++s) qnext[s] = *(const v4u*)(Z + (size_t)(qn + r) * ZLD + C_Q + hq * 64 + 16 * s + 8 * h); }
            bf16x8 qf[4];
            { float qv[4][8]; float ss = 0.f;
#pragma unroll
              for (int s = 0; s < 4; ++s) { const v4u qq = qraw[s];
                  qv[s][0] = bflo(qq.x); qv[s][1] = bfhi(qq.x); qv[s][2] = bflo(qq.y); qv[s][3] = bfhi(qq.y); qv[s][4] = bflo(qq.z); qv[s][5] = bfhi(qq.z); qv[s][6] = bflo(qq.w); qv[s][7] = bfhi(qq.w);
#pragma unroll
                  for (int e = 0; e < 8; ++e) ss += qv[s][e] * qv[s][e]; }
              ss += __shfl_xor(ss, 32);
              const float rstd = (0.125f * 1.4426950408889634f) / sqrtf(ss * (1.f / 64.f) + 1e-6f);
#pragma unroll
              for (int s = 0; s < 4; ++s) { const f32x4 g0 = *(const f32x4*)(qnw + 16 * s + 8 * h), g1 = *(const f32x4*)(qnw + 16 * s + 8 * h + 4);
                  u32x4 o; o.x = cvtpk2(qv[s][0] * rstd * g0.x, qv[s][1] * rstd * g0.y); o.y = cvtpk2(qv[s][2] * rstd * g0.z, qv[s][3] * rstd * g0.w);
                  o.z = cvtpk2(qv[s][4] * rstd * g1.x, qv[s][5] * rstd * g1.y); o.w = cvtpk2(qv[s][6] * rstd * g1.z, qv[s][7] * rstd * g1.w);
                  qf[s] = __builtin_bit_cast(bf16x8, o); } }
            f32x16 st[5];
            float sum = 0.f;
#pragma unroll
            for (int tt = 0; tt < 5; ++tt) {
                const int kl = 32 * (slab + tt);
                if (nb == 0 && slab + tt < 4) {
#pragma unroll
                    for (int g = 0; g < 16; ++g) st[tt][g] = 0.f;
                } else {
                    f32x16 acc;
#pragma unroll
                    for (int g = 0; g < 16; ++g) acc[g] = tbl[-32 * tt - 8 * (g >> 2) - (g & 3)];
#pragma unroll
                    for (int s = 0; s < 4; ++s) { const bf16x8 kf = *(const LAS bf16x8*)(Kl + (kl + r) * AT_LDK + 16 * s + 8 * h);
                        acc = __builtin_amdgcn_mfma_f32_32x32x16_bf16(kf, qf[s], acc, 0, 0, 0); }
#pragma unroll
                    for (int g = 0; g < 16; ++g) { const float e = __builtin_amdgcn_exp2f(acc[g]); st[tt][g] = e; sum += e; }
                }
            }
            sum += __shfl_xor(sum, 32);
            sum += __builtin_amdgcn_exp2f(sink);
            const float inv = 1.0f / sum;
            f32x16 o0 = (f32x16){0.f,0.f,0.f,0.f,0.f,0.f,0.f,0.f,0.f,0.f,0.f,0.f,0.f,0.f,0.f,0.f}, o1 = o0;
#pragma unroll
            for (int tt = 0; tt < 5; ++tt) {
                const int kl = 32 * (slab + tt);
#pragma unroll
                for (int s2 = 0; s2 < 2; ++s2) {
                    u32x4 pw; pw.x = cvtpk2(st[tt][8 * s2 + 0], st[tt][8 * s2 + 1]); pw.y = cvtpk2(st[tt][8 * s2 + 2], st[tt][8 * s2 + 3]); pw.z = cvtpk2(st[tt][8 * s2 + 4], st[tt][8 * s2 + 5]); pw.w = cvtpk2(st[tt][8 * s2 + 6], st[tt][8 * s2 + 7]);
                    const bf16x8 pf = __builtin_bit_cast(bf16x8, pw);
                    const int k0 = kl + 16 * s2 + 4 * h;
#pragma unroll
                    for (int dt = 0; dt < 2; ++dt) { const LAS bf16* vrow = Vl + (32 * dt + r) * AT_LDV + k0;
                        const u32x2 lo = *(const LAS u32x2*)(vrow), hi = *(const LAS u32x2*)(vrow + 8);
                        u32x4 vw; vw.x = lo.x; vw.y = lo.y; vw.z = hi.x; vw.w = hi.y;
                        const bf16x8 vf = __builtin_bit_cast(bf16x8, vw);
                        if (dt == 0) o0 = __builtin_amdgcn_mfma_f32_32x32x16_bf16(vf, pf, o0, 0, 0, 0); else o1 = __builtin_amdgcn_mfma_f32_32x32x16_bf16(vf, pf, o1, 0, 0, 0); }
                }
            }
            const int t = q0 + r;
#pragma unroll
            for (int dt = 0; dt < 2; ++dt)
#pragma unroll
                for (int g4 = 0; g4 < 4; ++g4) { const int d = 32 * dt + 8 * g4 + 4 * h;
                    const u32x2 gw = gwv[dt * 4 + g4];
                    const float g0 = bflo(gw.x), g1 = bfhi(gw.x), g2 = bflo(gw.y), g3 = bfhi(gw.y);
                    const f32x16& oo = dt == 0 ? o0 : o1;
                    const float y0 = oo[4 * g4 + 0] * inv * g0 * __builtin_amdgcn_rcpf(1.f + __expf(-g0)), y1 = oo[4 * g4 + 1] * inv * g1 * __builtin_amdgcn_rcpf(1.f + __expf(-g1));
                    const float y2 = oo[4 * g4 + 2] * inv * g2 * __builtin_amdgcn_rcpf(1.f + __expf(-g2)), y3 = oo[4 * g4 + 3] * inv * g3 * __builtin_amdgcn_rcpf(1.f + __expf(-g3));
                    u32x2 wv; wv.x = cvtpk2(y0, y1); wv.y = cvtpk2(y2, y3);
                    *(u32x2*)(Y + (size_t)t * DM + 1024 + hq * 64 + d) = wv; }
#pragma unroll
            for (int s = 0; s < 4; ++s) qraw[s] = qnext[s];
        }
    }
}

typedef float f32x2_t __attribute__((ext_vector_type(2))); typedef __bf16 bf16x2_t __attribute__((ext_vector_type(2)));
__device__ __forceinline__ unsigned cvtpk(float lo, float hi) { f32x2_t v = {lo, hi}; bf16x2_t b = __builtin_convertvector(v, bf16x2_t); return __builtin_bit_cast(unsigned, b); }
constexpr int LDM = 72;
constexpr int MB = 64 * LDM * 2;
constexpr int WFS = 68;
#define MFMA16(a, b, c) __builtin_amdgcn_mfma_f32_16x16x32_bf16(a, b, c, 0, 0, 0)
__device__ __forceinline__ bf16x8 ldfrag(const LAS bf16* M, int row0, int ks, int lane) {
    return *(const LAS bf16x8*)(M + (row0 + (lane & 15)) * LDM + 32 * ks + 8 * (lane >> 4));
}
__device__ __forceinline__ f32x4 mm_tile(const LAS bf16* X, int m0, const LAS bf16* Y, int n0, f32x4 acc, int lane) {
    acc = MFMA16(ldfrag(X, m0, 0, lane), ldfrag(Y, n0, 0, lane), acc);
    acc = MFMA16(ldfrag(X, m0, 1, lane), ldfrag(Y, n0, 1, lane), acc);
    return acc;
}
__device__ __forceinline__ void st_T(LAS bf16* M, int m0, int n0, f32x4 acc, int lane) {
    u32x2 w; w.x = cvtpk(acc[0], acc[1]); w.y = cvtpk(acc[2], acc[3]);
    *(LAS u32x2*)(M + (n0 + (lane & 15)) * LDM + m0 + 4 * (lane >> 4)) = w;
}
__device__ __forceinline__ void st_N(LAS bf16* M, int m0, int n0, f32x4 acc, int lane) {
    const unsigned w0 = cvtpk(acc[0], acc[1]), w1 = cvtpk(acc[2], acc[3]);
    LAS bf16* p = M + (m0 + 4 * (lane >> 4)) * LDM + n0 + (lane & 15);
    p[0] = (bf16)(w0 & 0xffffu); p[LDM] = (bf16)(w0 >> 16); p[2 * LDM] = (bf16)(w1 & 0xffffu); p[3 * LDM] = (bf16)(w1 >> 16);
}
__device__ __forceinline__ f32x4 ld4bf(const LAS bf16* p) { const u32x2 w = *(const LAS u32x2*)p; return (f32x4){bflo(w.x), bfhi(w.x), bflo(w.y), bfhi(w.y)}; }
__device__ __forceinline__ void shift8(const bf16* Z, int tok, int col, const float* mu, float* o) {
    const v4u zc = *(const v4u*)(Z + (size_t)tok * ZLD + col);
    v4u zp = (v4u){0u, 0u, 0u, 0u}; if (tok > 0) zp = *(const v4u*)(Z + (size_t)(tok - 1) * ZLD + col);
    const f32x4 m0 = *(const f32x4*)(mu + col), m1 = *(const f32x4*)(mu + col + 4);
    float c_, p_;
    c_ = bflo(zc.x); p_ = bflo(zp.x); o[0] = c_ + (p_ - c_) * m0.x;  c_ = bfhi(zc.x); p_ = bfhi(zp.x); o[1] = c_ + (p_ - c_) * m0.y;
    c_ = bflo(zc.y); p_ = bflo(zp.y); o[2] = c_ + (p_ - c_) * m0.z;  c_ = bfhi(zc.y); p_ = bfhi(zp.y); o[3] = c_ + (p_ - c_) * m0.w;
    c_ = bflo(zc.z); p_ = bflo(zp.z); o[4] = c_ + (p_ - c_) * m1.x;  c_ = bfhi(zc.z); p_ = bfhi(zp.z); o[5] = c_ + (p_ - c_) * m1.y;
    c_ = bflo(zc.w); p_ = bflo(zp.w); o[6] = c_ + (p_ - c_) * m1.z;  c_ = bfhi(zc.w); p_ = bfhi(zp.w); o[7] = c_ + (p_ - c_) * m1.w;
}
__device__ __forceinline__ void shift4(const bf16* Z, int tok, int col, const float* mu, float* o) {
    const u32x2 zc = *(const u32x2*)(Z + (size_t)tok * ZLD + col);
    u32x2 zp = (u32x2){0u, 0u}; if (tok > 0) zp = *(const u32x2*)(Z + (size_t)(tok - 1) * ZLD + col);
    const f32x4 m0 = *(const f32x4*)(mu + col);
    float c_, p_;
    c_ = bflo(zc.x); p_ = bflo(zp.x); o[0] = c_ + (p_ - c_) * m0.x;  c_ = bfhi(zc.x); p_ = bfhi(zp.x); o[1] = c_ + (p_ - c_) * m0.y;
    c_ = bflo(zc.y); p_ = bflo(zp.y); o[2] = c_ + (p_ - c_) * m0.z;  c_ = bfhi(zc.y); p_ = bfhi(zp.y); o[3] = c_ + (p_ - c_) * m0.w;
}
__device__ __forceinline__ v4u pack8(const float* v) { v4u w; w.x = cvtpk(v[0], v[1]); w.y = cvtpk(v[2], v[3]); w.z = cvtpk(v[4], v[5]); w.w = cvtpk(v[6], v[7]); return w; }
#define BARRIER() asm volatile("s_waitcnt lgkmcnt(0)\n\ts_barrier" ::: "memory")

__device__ __forceinline__ void pA_chunk(Frame& F, const Args& a, unsigned char* ws) {
    const bf16* Z = (const bf16*)(ws + WS_Z);
    bf16* PF = (bf16*)(ws + WS_PF); bf16* QF = (bf16*)(ws + WS_QF); bf16* RHF = (bf16*)(ws + WS_RHF); bf16* OIF = (bf16*)(ws + WS_OIF);
    float* BS = (float*)(ws + WS_BS);
    const bf16* W2T = (const bf16*)(ws + WS_W2T); const bf16* A2T = (const bf16*)(ws + WS_A2T);
    const float* mu = a.in[4]; const float* w0 = a.in[5]; const float* a0 = a.in[7];
    const float* k_k = a.in[9]; const float* k_a = a.in[10]; const float* r_k = a.in[11];
    LAS unsigned char* lds = F.lds;
#define LM(i) ((LAS bf16*)(lds + (i) * MB))
    LAS bf16* const mRT = LM(0); LAS bf16* const mBHT = LM(1); LAS bf16* const mKH = LM(2); LAS bf16* const mVVT = LM(3);
    LAS bf16* const mGH = LM(4);
    LAS bf16* const mBBRT = LM(6); LAS bf16* const mAT = LM(7); LAS bf16* const mBT = LM(8); LAS bf16* const mKT = LM(9);
    LAS bf16* const mA = LM(10); LAS bf16* const mAAT = LM(11); LAS bf16* const mS12 = LM(12);
    LAS bf16* const mTH = LM(7); LAS bf16* const mALM = LM(8);
    LAS float* const Wf = (LAS float*)(lds + 10 * MB);
    LAS float* const Af = (LAS float*)(lds + 12 * MB);
    LAS float* const GT = (LAS float*)(lds + 12 * MB + 64 * WFS * 4);
    LAS float* const CC = GT + 512;
    LAS bf16* const mZ1T = LM(9); LAS bf16* const mZ2T = LM(12);
    const int tid = F.tid, lane = F.lane, w = F.wave, q = lane >> 4, l15 = lane & 15;
    const int mi = w >> 1, nb = 2 * (w & 1);
    const int et = tid >> 3, oct = tid & 7;
    LAS bf16* const mBHr = LM(5); LAS bf16* const mVVr = LM(6);
    LAS float* const MUL = (LAS float*)(lds + 132096);
    { const int hb = (int)blockIdx.x & 15;
      if (tid < 320) { const int wh = tid >> 6, j = tid & 63; const int col = wh == 0 ? C_WL + j : wh == 1 ? C_AL + j : wh == 2 ? C_R + hb * 64 + j : wh == 3 ? C_K + hb * 64 + j : C_V + hb * 64 + j; MUL[tid] = mu[col]; } }
    v4u zc[5], zp[5];
#define PA_PREFETCH(ITEM) do { const int c_ = (ITEM) >> 4, h_ = (ITEM) & 15, tok_ = c_ * 64 + et, chb_ = h_ * 64 + 8 * oct; \
        const int cols_[5] = {C_WL + 8 * oct, C_AL + 8 * oct, C_R + chb_, C_K + chb_, C_V + chb_}; \
        _Pragma("unroll") for (int i_ = 0; i_ < 5; ++i_) { zc[i_] = *(const v4u*)(Z + (size_t)tok_ * ZLD + cols_[i_]); \
            zp[i_] = (v4u){0u, 0u, 0u, 0u}; if (tok_ > 0) zp[i_] = *(const v4u*)(Z + (size_t)(tok_ - 1) * ZLD + cols_[i_]); } } while (0)
#define PA_SHIFT(I, O) do { float c_, p_; const f32x4 ma_ = *(const LAS f32x4*)(MUL + (I) * 64 + 8 * oct), mb_ = *(const LAS f32x4*)(MUL + (I) * 64 + 8 * oct + 4); \
        c_ = bflo(zc[I].x); p_ = bflo(zp[I].x); O[0] = c_ + (p_ - c_) * ma_.x;  c_ = bfhi(zc[I].x); p_ = bfhi(zp[I].x); O[1] = c_ + (p_ - c_) * ma_.y; \
        c_ = bflo(zc[I].y); p_ = bflo(zp[I].y); O[2] = c_ + (p_ - c_) * ma_.z;  c_ = bfhi(zc[I].y); p_ = bfhi(zp[I].y); O[3] = c_ + (p_ - c_) * ma_.w; \
        c_ = bflo(zc[I].z); p_ = bflo(zp[I].z); O[4] = c_ + (p_ - c_) * mb_.x;  c_ = bfhi(zc[I].z); p_ = bfhi(zp[I].z); O[5] = c_ + (p_ - c_) * mb_.y; \
        c_ = bflo(zc[I].w); p_ = bflo(zp[I].w); O[6] = c_ + (p_ - c_) * mb_.z;  c_ = bfhi(zc[I].w); p_ = bfhi(zp[I].w); O[7] = c_ + (p_ - c_) * mb_.w; } while (0)
    if ((int)blockIdx.x < 2048) PA_PREFETCH((int)blockIdx.x);
    for (int item = blockIdx.x; item < 2048; item += F.G) {
        const int c = item >> 4, h = item & 15, T0 = c * 64, tok = T0 + et;
        const int chb = h * 64 + 8 * oct;
        BARRIER();
        bf16x8 fw[2][2], fa2[2][2];
#pragma unroll
        for (int nn = 0; nn < 2; ++nn)
#pragma unroll
            for (int ks = 0; ks < 2; ++ks) { fw[nn][ks] = *(const bf16x8*)(W2T + (size_t)(h * 64 + 16 * (nb + nn) + l15) * 64 + 32 * ks + 8 * q);
                fa2[nn][ks] = *(const bf16x8*)(A2T + (size_t)(h * 64 + 16 * (nb + nn) + l15) * 64 + 32 * ks + 8 * q); }
        float r8[8], k8[8], v8[8];
        { float wl8[8], al8[8];
          PA_SHIFT(0, wl8); PA_SHIFT(1, al8);
#pragma unroll
          for (int i = 0; i < 8; ++i) wl8[i] = 1.f - 2.f / (1.f + __expf(2.f * wl8[i]));
          *(LAS v4u*)(mTH + et * LDM + 8 * oct) = pack8(wl8); *(LAS v4u*)(mALM + et * LDM + 8 * oct) = pack8(al8); }
        PA_SHIFT(2, r8); PA_SHIFT(3, k8); PA_SHIFT(4, v8);
        BARRIER();
#pragma unroll
        for (int nn = 0; nn < 2; ++nn) { const int n0 = 16 * (nb + nn);
            f32x4 aw = (f32x4){0.f, 0.f, 0.f, 0.f}, aa = aw;
#pragma unroll
            for (int ks = 0; ks < 2; ++ks) { aw = MFMA16(ldfrag(mTH, 16 * mi, ks, lane), fw[nn][ks], aw); aa = MFMA16(ldfrag(mALM, 16 * mi, ks, lane), fa2[nn][ks], aa); }
#pragma unroll
            for (int rg = 0; rg < 4; ++rg) { Wf[(16 * mi + 4 * q + rg) * WFS + n0 + l15] = aw[rg]; Af[(16 * mi + 4 * q + rg) * WFS + n0 + l15] = aa[rg]; } }
        BARRIER();
        float logd[8], alr[8];
        { const f32x4 w0a = *(const f32x4*)(w0 + chb), w0b = *(const f32x4*)(w0 + chb + 4), a0a = *(const f32x4*)(a0 + chb), a0b = *(const f32x4*)(a0 + chb + 4);
          const f32x4 wsa = *(const LAS f32x4*)(Wf + et * WFS + 8 * oct), wsb = *(const LAS f32x4*)(Wf + et * WFS + 8 * oct + 4);
          const f32x4 asa = *(const LAS f32x4*)(Af + et * WFS + 8 * oct), asb = *(const LAS f32x4*)(Af + et * WFS + 8 * oct + 4);
#pragma unroll
          for (int i = 0; i < 8; ++i) {
              const float nx = -((i < 4 ? w0a[i & 3] : w0b[i & 3]) + (i < 4 ? wsa[i & 3] : wsb[i & 3]));
              const float sp = nx > 20.f ? nx : __logf(1.f + __expf(nx));
              logd[i] = -__expf(-sp - 0.5f);
              alr[i] = __builtin_amdgcn_rcpf(1.f + __expf(-((i < 4 ? a0a[i & 3] : a0b[i & 3]) + (i < 4 ? asa[i & 3] : asb[i & 3])))); }
          *(LAS f32x4*)(Wf + et * WFS + 8 * oct) = (f32x4){logd[0], logd[1], logd[2], logd[3]}; *(LAS f32x4*)(Wf + et * WFS + 8 * oct + 4) = (f32x4){logd[4], logd[5], logd[6], logd[7]}; }
        BARRIER();
        { const int g = tid >> 6, kc = tid & 63; float s = 0.f;
#pragma unroll
          for (int tt = 0; tt < 8; ++tt) { s += Wf[(8 * g + tt) * WFS + kc]; Wf[(8 * g + tt) * WFS + kc] = s; }
          GT[g * 64 + kc] = s; }
        BARRIER();
        { float cum[8], cC[8];
          { f32x4 offA = (f32x4){0.f, 0.f, 0.f, 0.f}, offB = offA, totA = offA, totB = offA;
#pragma unroll 2
            for (int g = 0; g < 8; ++g) { const f32x4 ga = *(const LAS f32x4*)(GT + g * 64 + 8 * oct), gb = *(const LAS f32x4*)(GT + g * 64 + 8 * oct + 4);
                totA += ga; totB += gb; if (g < (et >> 3)) { offA += ga; offB += gb; } }
            const f32x4 wa = *(const LAS f32x4*)(Wf + et * WFS + 8 * oct), wb = *(const LAS f32x4*)(Wf + et * WFS + 8 * oct + 4);
#pragma unroll
            for (int i = 0; i < 4; ++i) { cum[i] = wa[i] + offA[i]; cum[4 + i] = wb[i] + offB[i]; cC[i] = totA[i]; cC[4 + i] = totB[i]; } }
          float kk[8], km[8]; float n2 = 0.f, bsum = 0.f;
          { const f32x4 kka = *(const f32x4*)(k_k + chb), kkb = *(const f32x4*)(k_k + chb + 4), kaa = *(const f32x4*)(k_a + chb), kab = *(const f32x4*)(k_a + chb + 4), rka = *(const f32x4*)(r_k + chb), rkb = *(const f32x4*)(r_k + chb + 4);
#pragma unroll
            for (int i = 0; i < 8; ++i) { kk[i] = k8[i] * (i < 4 ? kka[i & 3] : kkb[i & 3]); n2 += kk[i] * kk[i]; km[i] = k8[i] * (1.f + (alr[i] - 1.f) * (i < 4 ? kaa[i & 3] : kab[i & 3])); bsum += r8[i] * km[i] * (i < 4 ? rka[i & 3] : rkb[i & 3]); } }
          n2 += __shfl_xor(n2, 1); n2 += __shfl_xor(n2, 2); n2 += __shfl_xor(n2, 4);
          bsum += __shfl_xor(bsum, 1); bsum += __shfl_xor(bsum, 2); bsum += __shfl_xor(bsum, 4);
          const float rs = __builtin_amdgcn_rsqf(fmaxf(n2, 1e-24f));
          if (oct == 0) BS[(size_t)tok * 16 + h] = bsum;
          if (et == 0) { *(LAS f32x4*)(CC + 8 * oct) = (f32x4){cC[0], cC[1], cC[2], cC[3]}; *(LAS f32x4*)(CC + 8 * oct + 4) = (f32x4){cC[4], cC[5], cC[6], cC[7]}; }
          float vAt[8], vBt[8], vKt[8], vRt[8], vBh[8], vKh[8];
#pragma unroll
          for (int i = 0; i < 8; ++i) { kk[i] *= rs; const float bb = kk[i] * alr[i];
              const float e1 = __expf(cum[i] - logd[i]), e2 = __expf(-cum[i]), e3 = __expf(cum[i]), e4 = __expf(cC[i] - cum[i]);
              vAt[i] = -kk[i] * e1; vBt[i] = bb * e2; vKt[i] = km[i] * e2; vRt[i] = r8[i] * e3; vBh[i] = bb * e4; vKh[i] = km[i] * e4; }
          *(LAS v4u*)(mAT + et * LDM + 8 * oct) = pack8(vAt); *(LAS v4u*)(mBT + et * LDM + 8 * oct) = pack8(vBt); *(LAS v4u*)(mKT + et * LDM + 8 * oct) = pack8(vKt);
          *(LAS v4u*)(mRT + et * LDM + 8 * oct) = pack8(vRt); *(LAS v4u*)(mKH + et * LDM + 8 * oct) = pack8(vKh);
          *(LAS v4u*)(mBHr + et * LDM + 8 * oct) = pack8(vBh); *(LAS v4u*)(mVVr + et * LDM + 8 * oct) = pack8(v8);
        }
        BARRIER();
#pragma unroll
        for (int nn = 0; nn < 2; ++nn) { const int m0 = 16 * mi, n0 = 16 * (nb + nn);
            const int so = (m0 + 4 * q) * LDM + n0 + l15, dofs = (n0 + l15) * LDM + m0 + 4 * q;
            { const unsigned a0_ = mAT[so], a1_ = mAT[so + LDM], a2_ = mAT[so + 2 * LDM], a3_ = mAT[so + 3 * LDM]; *(LAS u32x2*)(mGH + dofs) = (u32x2){a0_ | (a1_ << 16), a2_ | (a3_ << 16)}; }
            { const unsigned a0_ = mBHr[so], a1_ = mBHr[so + LDM], a2_ = mBHr[so + 2 * LDM], a3_ = mBHr[so + 3 * LDM]; *(LAS u32x2*)(mBHT + dofs) = (u32x2){a0_ | (a1_ << 16), a2_ | (a3_ << 16)}; }
            { const unsigned a0_ = mVVr[so], a1_ = mVVr[so + LDM], a2_ = mVVr[so + 2 * LDM], a3_ = mVVr[so + 3 * LDM]; *(LAS u32x2*)(mVVT + dofs) = (u32x2){a0_ | (a1_ << 16), a2_ | (a3_ << 16)}; } }
        BARRIER();
        f32x4 ghG[2], ghH[2], bkr[2];
        const f32x4 zero4 = (f32x4){0.f, 0.f, 0.f, 0.f};
#pragma unroll
        for (int nn = 0; nn < 2; ++nn) { const int j0 = 16 * mi, t0 = 16 * (nb + nn);
            const bf16x8 fB0 = ldfrag(mBT, j0, 0, lane), fB1 = ldfrag(mBT, j0, 1, lane), fK0 = ldfrag(mKT, j0, 0, lane), fK1 = ldfrag(mKT, j0, 1, lane);
            const bf16x8 fA0 = ldfrag(mAT, t0, 0, lane), fA1 = ldfrag(mAT, t0, 1, lane), fR0 = ldfrag(mRT, t0, 0, lane), fR1 = ldfrag(mRT, t0, 1, lane);
            f32x4 dab = MFMA16(fB0, fA0, zero4); dab = MFMA16(fB1, fA1, dab);
            f32x4 dbr = MFMA16(fB0, fR0, zero4); dbr = MFMA16(fB1, fR1, dbr);
            f32x4 dkr = MFMA16(fK0, fR0, zero4); dkr = MFMA16(fK1, fR1, dkr);
            f32x4 dak = MFMA16(fA0, fK0, zero4); dak = MFMA16(fA1, fK1, dak);
#pragma unroll
            for (int rg = 0; rg < 4; ++rg) { const int jj = j0 + 4 * q + rg, tt = t0 + l15;
                if (!(jj < tt)) dab[rg] = 0.f; if (!(jj <= tt)) { dbr[rg] = 0.f; dkr[rg] = 0.f; }
                const int t2 = t0 + 4 * q + rg, j2 = j0 + l15; if (!(j2 < t2)) dak[rg] = 0.f; }
            st_N(mA, j0, t0, dab, lane); st_T(mAAT, j0, t0, dab, lane);
            st_T(mBBRT, j0, t0, dbr, lane);
            st_T(mGH + 64 * LDM, t0, j0, dak, lane);
            ghH[nn] = dak; bkr[nn] = dkr; }
        BARRIER();
        if (item + F.G < 2048) PA_PREFETCH(item + F.G);
#pragma unroll
        for (int nn = 0; nn < 2; ++nn) ghG[nn] = ld4bf(mGH + (16 * mi + l15) * LDM + 16 * (nb + nn) + 4 * q);
#pragma unroll 1
        for (int s = 0; s < 6; ++s) {
            LAS bf16* const cA = (s & 1) ? LM(7) : LM(10); LAS bf16* const cAT = (s & 1) ? LM(8) : LM(11);
            LAS bf16* const nA = (s & 1) ? LM(10) : LM(7); LAS bf16* const nAT = (s & 1) ? LM(11) : LM(8);
            f32x4 sq[2];
#pragma unroll
            for (int nn = 0; nn < 2; ++nn) { const int t0 = 16 * (nb + nn);
                const bf16x8 fT0 = ldfrag(cAT, t0, 0, lane), fT1 = ldfrag(cAT, t0, 1, lane);
                ghG[nn] = MFMA16(fT0, ldfrag(mGH, 16 * mi, 0, lane), ghG[nn]); ghG[nn] = MFMA16(fT1, ldfrag(mGH, 16 * mi, 1, lane), ghG[nn]);
                ghH[nn] = MFMA16(fT0, ldfrag(mGH, 64 + 16 * mi, 0, lane), ghH[nn]); ghH[nn] = MFMA16(fT1, ldfrag(mGH, 64 + 16 * mi, 1, lane), ghH[nn]);
                if (s < 5) { sq[nn] = MFMA16(ldfrag(cA, 16 * mi, 0, lane), fT0, zero4); sq[nn] = MFMA16(ldfrag(cA, 16 * mi, 1, lane), fT1, sq[nn]); } }
            BARRIER();
#pragma unroll
            for (int nn = 0; nn < 2; ++nn) { const int t0 = 16 * (nb + nn);
                st_T(mGH, t0, 16 * mi, ghG[nn], lane); st_T(mGH, t0, 64 + 16 * mi, ghH[nn], lane);
                if (s < 5) { st_N(nA, 16 * mi, t0, sq[nn], lane); st_T(nAT, 16 * mi, t0, sq[nn], lane); } }
            BARRIER();
        }
        { bf16* PFi = PF + (size_t)item * 4096; bf16* RHFi = RHF + (size_t)item * 4096;
          const int k0 = 16 * mi, ks_o = k0 >> 5, hb = 4 * ((k0 >> 4) & 1);
          const bf16x8 fG0 = ldfrag(mGH, k0, 0, lane), fG1 = ldfrag(mGH, k0, 1, lane), fH0 = ldfrag(mGH, 64 + k0, 0, lane), fH1 = ldfrag(mGH, 64 + k0, 1, lane);
#pragma unroll
          for (int nn = 0; nn < 2; ++nn) { const int n0 = 16 * (nb + nn), ni = nb + nn;
              const bf16x8 fBh0 = ldfrag(mBHT, n0, 0, lane), fBh1 = ldfrag(mBHT, n0, 1, lane), fBr0 = ldfrag(mBBRT, n0, 0, lane), fBr1 = ldfrag(mBBRT, n0, 1, lane);
              f32x4 dp = MFMA16(fG0, fBh0, zero4); dp = MFMA16(fG1, fBh1, dp);
#pragma unroll
              for (int rg = 0; rg < 4; ++rg) if (k0 + 4 * q + rg == n0 + l15) dp[rg] += __expf(CC[k0 + 4 * q + rg]);
              { u32x2 wv; wv.x = cvtpk(dp[0], dp[1]); wv.y = cvtpk(dp[2], dp[3]); *(u32x2*)(PFi + ((ni * 2 + ks_o) * 64 + lane) * 8 + hb) = wv; }
              f32x4 dr = ld4bf(mRT + (n0 + l15) * LDM + k0 + 4 * q);
              dr = MFMA16(fG0, fBr0, dr); dr = MFMA16(fG1, fBr1, dr);
              { u32x2 wv; wv.x = cvtpk(dr[0], dr[1]); wv.y = cvtpk(dr[2], dr[3]); *(u32x2*)(RHFi + ((ni * 2 + ks_o) * 64 + lane) * 8 + hb) = wv; }
              f32x4 d1;
#pragma unroll
              for (int rg = 0; rg < 4; ++rg) d1[rg] = bf2f(mKH[(k0 + 4 * q + rg) * LDM + n0 + l15]);
              d1 = MFMA16(fH0, fBh0, d1); d1 = MFMA16(fH1, fBh1, d1);
              f32x4 d2 = bkr[nn]; d2 = MFMA16(fH0, fBr0, d2); d2 = MFMA16(fH1, fBr1, d2);
              bkr[nn] = d2; ghH[nn] = d1; }
          BARRIER();
#pragma unroll
          for (int nn = 0; nn < 2; ++nn) { const int n0 = 16 * (nb + nn); st_T(mZ1T, k0, n0, ghH[nn], lane); st_T(mZ2T, k0, n0, bkr[nn], lane); }
        }
        BARRIER();
        { bf16* QFi = QF + (size_t)item * 4096; bf16* OIFi = OIF + (size_t)item * 4096;
#pragma unroll
          for (int nn = 0; nn < 2; ++nn) { const int ni = nb + nn, n0 = 16 * ni;
              f32x4 dq = mm_tile(mZ1T, 16 * mi, mVVT, n0, zero4, lane);
              { u32x2 wv; wv.x = cvtpk(dq[0], dq[1]); wv.y = cvtpk(dq[2], dq[3]); *(u32x2*)(QFi + ((ni * 4 + mi) * 64 + lane) * 4) = wv; }
              f32x4 dov = mm_tile(mVVT, 16 * mi, mZ2T, n0, zero4, lane);
              { u32x2 wv; wv.x = cvtpk(dov[0], dov[1]); wv.y = cvtpk(dov[2], dov[3]); *(u32x2*)(OIFi + ((ni * 4 + mi) * 64 + lane) * 4) = wv; } }
        }
    }
#undef LM
#undef PA_PREFETCH
#undef PA_SHIFT
}

constexpr int SC_RING = 12, SC_SLOT = 10240, SC_CTL = SC_RING * SC_SLOT;
struct ScanFr { bf16x8 p[8]; u32x2 q[4]; unsigned fl; };
__device__ __forceinline__ void scan_issue(ScanFr& f, const LAS unsigned char* lds, volatile LAS unsigned* flag, int c, int lane) {
    const int s = c % SC_RING;
    f.fl = flag[s];
    asm volatile("" ::: "memory");
    const LAS unsigned char* slot = lds + s * SC_SLOT;
#pragma unroll
    for (int i = 0; i < 8; ++i) f.p[i] = *(const LAS bf16x8*)(slot + (i * 64 + lane) * 16);
#pragma unroll
    for (int i = 0; i < 4; ++i) f.q[i] = *(const LAS u32x2*)(slot + 8192 + (i * 64 + lane) * 8);
}
__device__ __forceinline__ void scan_commit(ScanFr& f, const LAS unsigned char* lds, volatile LAS unsigned* flag, volatile LAS unsigned* prog, int c, int lane) {
    if (f.fl != (unsigned)(c + 1)) {
        while (flag[c % SC_RING] != (unsigned)(c + 1)) __builtin_amdgcn_s_sleep(1);
        asm volatile("" ::: "memory");
        scan_issue(f, lds, flag, c, lane);
    }
    asm volatile("s_waitcnt lgkmcnt(0)" ::: "memory");
    if (lane == 0) prog[0] = (unsigned)(c + 1);
}
__device__ __forceinline__ void scan_step(f32x4 (&st)[4], const ScanFr& f, bf16* SFc, int lane) {
    u32x4 b0, b1;
    b0.x = cvtpk(st[0][0], st[0][1]); b0.y = cvtpk(st[0][2], st[0][3]); b0.z = cvtpk(st[1][0], st[1][1]); b0.w = cvtpk(st[1][2], st[1][3]);
    b1.x = cvtpk(st[2][0], st[2][1]); b1.y = cvtpk(st[2][2], st[2][3]); b1.z = cvtpk(st[3][0], st[3][1]); b1.w = cvtpk(st[3][2], st[3][3]);
    *(u32x4*)(SFc + (0 * 64 + lane) * 8) = b0; *(u32x4*)(SFc + (1 * 64 + lane) * 8) = b1;
    const bf16x8 f0 = __builtin_bit_cast(bf16x8, b0), f1 = __builtin_bit_cast(bf16x8, b1);
    f32x4 acc[4];
#pragma unroll
    for (int i = 0; i < 4; ++i) { acc[i] = (f32x4){bflo(f.q[i].x), bfhi(f.q[i].x), bflo(f.q[i].y), bfhi(f.q[i].y)}; acc[i] = MFMA16(f.p[2 * i], f0, acc[i]); }
#pragma unroll
    for (int i = 0; i < 4; ++i) st[i] = MFMA16(f.p[2 * i + 1], f1, acc[i]);
}
__device__ __forceinline__ void pB_scan(Frame& F, unsigned char* ws) {
    const bf16* PF = (const bf16*)(ws + WS_PF); const bf16* QF = (const bf16*)(ws + WS_QF); bf16* SF = (bf16*)(ws + WS_SF);
    const int h = blockIdx.x >> 2, vt = blockIdx.x & 3, lane = F.lane;
    volatile LAS unsigned* flag = (volatile LAS unsigned*)(F.lds + SC_CTL);
    volatile LAS unsigned* prog = flag + 16;
    if (F.tid < 32) flag[F.tid] = 0u;
    __syncthreads();
    if (F.wave != 0) {
        for (int c = F.wave - 1; c < 128; c += 7) {
            const size_t it = (size_t)c * 16 + h;
            v4u pv[8], qv[2];
#pragma unroll
            for (int i = 0; i < 8; ++i) pv[i] = *(const v4u*)(PF + it * 4096 + (i * 64 + lane) * 8);
#pragma unroll
            for (int i = 0; i < 2; ++i) qv[i] = *(const v4u*)(QF + it * 4096 + vt * 1024 + (i * 64 + lane) * 8);
            while ((int)prog[0] < c - SC_RING + 1) __builtin_amdgcn_s_sleep(4);
            asm volatile("" ::: "memory");
            LAS unsigned char* slot = F.lds + (c % SC_RING) * SC_SLOT;
#pragma unroll
            for (int i = 0; i < 8; ++i) *(LAS v4u*)(slot + (i * 64 + lane) * 16) = pv[i];
#pragma unroll
            for (int i = 0; i < 2; ++i) *(LAS v4u*)(slot + 8192 + (i * 64 + lane) * 16) = qv[i];
            asm volatile("s_waitcnt lgkmcnt(0)" ::: "memory");
            if (lane == 0) flag[c % SC_RING] = (unsigned)(c + 1);
        }
        return;
    }
    f32x4 st[4];
#pragma unroll
    for (int i = 0; i < 4; ++i) st[i] = (f32x4){0.f, 0.f, 0.f, 0.f};
    bf16* SFh = SF + (size_t)h * 4096 + vt * 1024;
    ScanFr fa, fb;
    scan_issue(fa, F.lds, flag, 0, lane); scan_commit(fa, F.lds, flag, prog, 0, lane);
    for (int c = 0; c < 126; c += 2) {
        scan_issue(fb, F.lds, flag, c + 1, lane);
        scan_step(st, fa, SFh + (size_t)c * 65536, lane);
        scan_commit(fb, F.lds, flag, prog, c + 1, lane);
        scan_issue(fa, F.lds, flag, c + 2, lane);
        scan_step(st, fb, SFh + (size_t)(c + 1) * 65536, lane);
        scan_commit(fa, F.lds, flag, prog, c + 2, lane);
    }
    scan_issue(fb, F.lds, flag, 127, lane);
    scan_step(st, fa, SFh + (size_t)126 * 65536, lane);
    scan_commit(fb, F.lds, flag, prog, 127, lane);
    scan_step(st, fb, SFh + (size_t)127 * 65536, lane);
}

__device__ __forceinline__ void pC_out(Frame& F, const Args& a, unsigned char* ws) {
    const bf16* Z = (const bf16*)(ws + WS_Z); bf16* Y = (bf16*)(ws + WS_H);
    const bf16* RHF = (const bf16*)(ws + WS_RHF); const bf16* OIF = (const bf16*)(ws + WS_OIF); const bf16* SF = (const bf16*)(ws + WS_SF);
    const float* BS = (const float*)(ws + WS_BS);
    const float* mu = a.in[4]; const float* lnx_w = a.in[12]; const float* lnx_b = a.in[13];
    const int gw = blockIdx.x * NWAVES + F.wave, NGW = F.G * NWAVES, lane = F.lane, q = lane >> 4, l15 = lane & 15;
    for (int u = gw; u < 8192; u += NGW) {
        const int item = u >> 2, tt = u & 3, c = item >> 4, h = item & 15, t = c * 64 + 16 * tt + l15;
        const bf16x8 r0 = *(const bf16x8*)(RHF + (size_t)item * 4096 + ((tt * 2 + 0) * 64 + lane) * 8), r1 = *(const bf16x8*)(RHF + (size_t)item * 4096 + ((tt * 2 + 1) * 64 + lane) * 8);
        f32x4 o[4]; float sum = 0.f;
#pragma unroll
        for (int vt = 0; vt < 4; ++vt) {
            const bf16x8 s0 = *(const bf16x8*)(SF + (size_t)item * 4096 + ((vt * 2 + 0) * 64 + lane) * 8), s1 = *(const bf16x8*)(SF + (size_t)item * 4096 + ((vt * 2 + 1) * 64 + lane) * 8);
            const u32x2 oi = *(const u32x2*)(OIF + (size_t)item * 4096 + ((tt * 4 + vt) * 64 + lane) * 4);
            f32x4 acc = (f32x4){bflo(oi.x), bfhi(oi.x), bflo(oi.y), bfhi(oi.y)};
            acc = MFMA16(s0, r0, acc); acc = MFMA16(s1, r1, acc);
            o[vt] = acc; sum += (acc[0] + acc[1]) + (acc[2] + acc[3]); }
        sum += __shfl_xor(sum, 16); sum += __shfl_xor(sum, 32);
        const float mean = sum * (1.f / 64.f); float var = 0.f;
#pragma unroll
        for (int vt = 0; vt < 4; ++vt)
#pragma unroll
            for (int rg = 0; rg < 4; ++rg) { const float d = o[vt][rg] - mean; var += d * d; }
        var += __shfl_xor(var, 16); var += __shfl_xor(var, 32);
        const float rstd = 1.0f / sqrtf(var * (1.f / 64.f) + 64e-5f);
        const float bs = BS[(size_t)t * 16 + h];
#pragma unroll
        for (int vt = 0; vt < 4; ++vt) { const int ch = h * 64 + 16 * vt + 4 * q;
            float vv[4], gg[4]; shift4(Z, t, C_V + ch, mu, vv); shift4(Z, t, C_G + ch, mu, gg);
            const f32x4 lw = *(const f32x4*)(lnx_w + ch), lb = *(const f32x4*)(lnx_b + ch);
            float y[4];
#pragma unroll
            for (int rg = 0; rg < 4; ++rg) { const float val = (o[vt][rg] - mean) * rstd * lw[rg] + lb[rg] + bs * vv[rg]; y[rg] = val * gg[rg] / (1.f + __expf(-gg[rg])); }
            u32x2 wv; wv.x = cvtpk(y[0], y[1]); wv.y = cvtpk(y[2], y[3]);
            *(u32x2*)(Y + (size_t)t * DM + ch) = wv; }
    }
}

__global__ void __launch_bounds__(NTHR, 2) fwd_kernel(Args args) {
    extern __shared__ __attribute__((aligned(16))) unsigned char lds[];
    Frame F;
    F.lds = (LAS unsigned char*)lds;
    F.MISC = (volatile LAS unsigned*)(F.lds + MISC_OFF);
    F.tid = threadIdx.x; F.lane = F.tid & 63; F.wave = __builtin_amdgcn_readfirstlane(F.tid >> 6);
    F.G = gridDim.x; { const int bx = blockIdx.x; F.vcu = (F.G % 8 == 0) ? (bx % 8) * (F.G / 8) + bx / 8 : bx; }
    unsigned char* ws = args.ws;
    F.ctl = (gu32*)(ws + WS_CTL);
    for (int u = F.tid; u < (LDS_BYTES - LDSCTL_OFF) / 4; u += NTHR) ((LAS unsigned*)(F.lds + LDSCTL_OFF))[u] = 0u;
    __syncthreads();
#if MK_FUSED
    XcdBarrier bar = xcd_barrier_post((unsigned*)(F.ctl + CW_BAR), F.MISC + 8);
#define GRID_BAR() xcd_barrier(bar)
#else
#define GRID_BAR() do {} while (0)
#endif
    const int lo = args.ph_lo, hi = args.ph_hi;
#define IN(k) (lo <= (k) && (k) < hi)
#define BOTH(k) (IN(k) && IN((k) + 1))
    if (IN(0)) { REP(0) p0_prologue(F, args, ws); if (BOTH(0)) GRID_BAR();
#if PROBE_DUP == 9
        for (int i_ = 0; i_ < 8; ++i_) GRID_BAR();
#endif
    }
    if (IN(1)) {
        pg8::Gemm g{(const pg8::bf16_t*)(ws + WS_H), (const pg8::bf16_t*)(ws + WS_WTIN), SEQ, NPAD, DM}; pg8::StaticOrder S; S.init(SEQ, NPAD, F.G, (int)blockIdx.x);
        pg8::EpiBf16 E{(pg8::bf16_t*)(ws + WS_Z), ZLD, (pg8::bf16_t*)(ws + WS_VT)};
        REP(1) pg8::gemm_phase<pg8::EpiBf16, pg8::StaticOrder, true, true>(F.lds, g, S, E);
        if (BOTH(1)) GRID_BAR();
    }
    if (IN(2)) { REP(2) pA_chunk(F, args, ws); if (BOTH(2)) GRID_BAR(); }
    if (IN(3)) {
#if PROBE_SEQ
        REP(6) p3_attn(F, args, ws, (int)blockIdx.x, F.G);
        GRID_BAR();
        if (blockIdx.x < 64) { REP(3) pB_scan(F, ws); }
#else
        if (blockIdx.x < 64) { REP(3) pB_scan(F, ws); } else { REP(6) p3_attn(F, args, ws, (int)blockIdx.x - 64, F.G - 64); }
#endif
        if (BOTH(3)) GRID_BAR();
    }
    if (IN(4)) { REP(4) pC_out(F, args, ws); if (BOTH(4)) GRID_BAR(); }
    if (IN(5)) {
        pg8::Gemm g{(const pg8::bf16_t*)(ws + WS_H), (const pg8::bf16_t*)(ws + WS_WTOUT), SEQ, DM, DM}; pg8::StaticOrder S; S.init(SEQ, DM, F.G, (int)blockIdx.x);
        pg8::EpiResF32 E{args.in[0], args.out, DM};
        REP(5) pg8::gemm_phase<pg8::EpiResF32, pg8::StaticOrder, true, true>(F.lds, g, S, E);
    }
#undef IN
#undef BOTH
}

extern "C" void kernel_launch(void* const* d_in, const int* in_sizes, int n_in, void* d_out, int out_size, void* d_ws, size_t ws_size, hipStream_t stream) {
    static int grid = 0;
    if (grid == 0) {
        if (n_in != 18 || in_sizes[0] != SEQ * DM || out_size != SEQ * DM || ws_size < WS_END) { fprintf(stderr, "kernel_launch: unexpected shapes (n_in %d, in0 %d, out %d, ws %zu)\n", n_in, n_in > 0 ? in_sizes[0] : -1, out_size, ws_size); grid = -1; return; }
        int dev = 0, cus = 0;
        if (hipGetDevice(&dev) != hipSuccess || hipDeviceGetAttribute(&cus, hipDeviceAttributeMultiprocessorCount, dev) != hipSuccess) { grid = -1; return; }
        if (hipFuncSetAttribute((const void*)fwd_kernel, hipFuncAttributeMaxDynamicSharedMemorySize, LDS_BYTES) != hipSuccess) { fprintf(stderr, "kernel_launch: hipFuncSetAttribute failed\n"); grid = -1; return; }
        (void)hipGetLastError();
        grid = cus;
        if (grid != 256) fprintf(stderr, "kernel_launch: %d CUs (built for 256)\n", grid);
    }
    if (grid < 0) return;
    (void)hipMemsetAsync((char*)d_ws + WS_CTL, 0, CTL_ZERO_BYTES, stream);
    Args a{};
    for (int i = 0; i < 18; ++i) a.in[i] = (const float*)d_in[i];
    a.out = (float*)d_out; a.ws = (unsigned char*)d_ws;
#if MK_FUSED
    a.ph_lo = 0; a.ph_hi = N_PHASES;
    hipLaunchKernelGGL(fwd_kernel, dim3(grid), dim3(NTHR), LDS_BYTES, stream, a);
#else
    for (int p = 0; p < N_PHASES; ++p) { a.ph_lo = p; a.ph_hi = p + 1; hipLaunchKernelGGL(fwd_kernel, dim3(grid), dim3(NTHR), LDS_BYTES, stream, a); }
#endif
}
```
